# Optimizing an MI355X kernel written in HIP

```python
import jax
import jax.numpy as jnp
from jax import lax
import numpy as np

D_MODEL = 1024
BATCH = 4
SEQ = 4096
DEPTH = 4

GRID_W = 64
CTX_LEN = 256
D_MIX = 2 * D_MODEL
D_SSD = D_MIX // 2
SSD_HEADDIM = 64
SSD_HEADS = D_SSD // SSD_HEADDIM
SSD_GROUPS = 2
SSD_HEADS_PER_GROUP = SSD_HEADS // SSD_GROUPS
SSD_STATE = 128
SSD_CHUNK = 128
CONV_K = 3
D_CONV_CH = D_SSD + 2 * SSD_GROUPS * SSD_STATE
D_S5 = D_MIX // 4
S5_GROUP = 16
S5_GROUPS = D_S5 // S5_GROUP
S5_STATE = 64
D_FNET = D_MIX // 4
FNET_HEADS = 4
FNET_HEAD_DIM = D_FNET // FNET_HEADS
PROJ_SIZES = (D_SSD, D_CONV_CH, 2 * SSD_HEADS, D_S5, D_S5, D_FNET, D_FNET)
SPLIT_POINTS = tuple(int(v) for v in np.cumsum(PROJ_SIZES)[:-1])
D_IN_PROJ = sum(PROJ_SIZES)
EPS = 1e-6

kernel_name = 'hybrid_ssd_s5_fnet_prefix_block'


def rmsnorm(v, g):
    vf = v.astype(jnp.float32)
    vf = vf * lax.rsqrt(jnp.mean(vf * vf, axis=-1, keepdims=True) + EPS)
    return vf.astype(v.dtype) * g


def maybe_flip(t, rev):
    return jnp.flip(t, axis=1) if rev else t


def conv_grid(v, w, bias):
    b, l, ch = v.shape
    rows = l // GRID_W
    img = v.reshape(b, rows, GRID_W, ch)
    out = lax.conv_general_dilated(img, w[:, :, None, :], (1, 1), 'SAME',
                                   dimension_numbers=('NHWC', 'HWIO', 'NHWC'), feature_group_count=ch)
    return out.reshape(b, l, ch) + bias


def conv_seq(v, w_row, bias):
    ch = v.shape[-1]
    out = lax.conv_general_dilated(v, w_row[:, None, :], (1,), 'SAME',
                                   dimension_numbers=('NWC', 'WIO', 'NWC'), feature_group_count=ch)
    return out + bias


def ssd_scan(x, a, bm, cm, h0):
    b, l = x.shape[:2]
    q = SSD_CHUNK
    nc = l // q
    x = x.reshape(b, nc, q, SSD_GROUPS, SSD_HEADS_PER_GROUP, SSD_HEADDIM)
    a = a.reshape(b, nc, q, SSD_GROUPS, SSD_HEADS_PER_GROUP)
    bm = bm.reshape(b, nc, q, SSD_GROUPS, SSD_STATE)
    cm = cm.reshape(b, nc, q, SSD_GROUPS, SSD_STATE)
    a_cum = jnp.cumsum(a, axis=2)
    seg = a_cum[:, :, :, None] - a_cum[:, :, None, :]
    mask = jnp.tril(jnp.ones((q, q), bool))[:, :, None, None]
    decay = jnp.where(mask, jnp.exp(jnp.where(mask, seg, 0.0)), 0.0)
    cb = jnp.einsum('bcign,bcjgn->bcijg', cm, bm)
    y_diag = jnp.einsum('bcijgh,bcjghp->bcighp', cb[..., None] * decay, x)
    decay_to_end = jnp.exp(a_cum[:, :, -1:] - a_cum)
    states = jnp.einsum('bcjgn,bcjgh,bcjghp->bcghpn', bm, decay_to_end, x)
    chunk_decay = jnp.exp(a_cum[:, :, -1])

    def step(h, inp):
        st, dec = inp
        return h * dec[..., None, None] + st, h

    h_final, h_in = lax.scan(step, h0, (jnp.moveaxis(states, 1, 0), jnp.moveaxis(chunk_decay, 1, 0)))
    h_in = jnp.moveaxis(h_in, 0, 1)
    y_off = jnp.einsum('bcign,bcghpn->bcighp', cm, h_in) * jnp.exp(a_cum)[..., None]
    y = (y_diag + y_off).reshape(b, l, SSD_HEADS, SSD_HEADDIM)
    return y, h_final


def ssd_branch(zl, xbcl, dtl, zc, xbcc, dtc, conv_w, conv_b, dt_bias, a_log, d_skip, g_norm, need_ctx):
    f32 = jnp.float32
    b = zl.shape[0]
    xbcl = jax.nn.silu(conv_grid(xbcl, conv_w, conv_b))
    xbcc = jax.nn.silu(conv_seq(xbcc, conv_w[CONV_K // 2], conv_b))
    a_neg = -jnp.exp(a_log.astype(f32))

    def prep(xbc, dt_raw):
        l = xbc.shape[1]
        xs, bm, cm = jnp.split(xbc.astype(f32), [D_SSD, D_SSD + SSD_GROUPS * SSD_STATE], axis=-1)
        dt = jax.nn.softplus(dt_raw.astype(f32).reshape(b, l, 2, SSD_HEADS) + dt_bias.astype(f32))
        return (xs.reshape(b, l, SSD_HEADS, SSD_HEADDIM), bm.reshape(b, l, SSD_GROUPS, SSD_STATE),
                cm.reshape(b, l, SSD_GROUPS, SSD_STATE), dt)

    xl_, bl_, cl_, dtl_ = prep(xbcl, dtl)
    xc_, bc_, cc_, dtc_ = prep(xbcc, dtc)
    dsk = d_skip.astype(f32)[:, None]
    yl = dsk * xl_
    yc = dsk * xc_ if need_ctx else None
    h0 = jnp.zeros((b, SSD_GROUPS, SSD_HEADS_PER_GROUP, SSD_HEADDIM, SSD_STATE), f32)
    for d in range(2):
        rev = d == 1
        y_c, h_c = ssd_scan(maybe_flip(xc_ * dtc_[:, :, d, :, None], rev),
                            maybe_flip(dtc_[:, :, d] * a_neg[d], rev),
                            maybe_flip(bc_, rev), maybe_flip(cc_, rev), h0)
        y_l, _ = ssd_scan(maybe_flip(xl_ * dtl_[:, :, d, :, None], rev),
                          maybe_flip(dtl_[:, :, d] * a_neg[d], rev),
                          maybe_flip(bl_, rev), maybe_flip(cl_, rev), h_c)
        yl = yl + maybe_flip(y_l, rev)
        if need_ctx:
            yc = yc + maybe_flip(y_c, rev)

    def gated_norm(y, z):
        l = y.shape[1]
        v = (y.reshape(b, l, D_SSD) * jax.nn.silu(z.astype(f32))).reshape(b, l, SSD_GROUPS, D_SSD // SSD_GROUPS)
        v = v * lax.rsqrt(jnp.mean(v * v, axis=-1, keepdims=True) + EPS)
        return (v.reshape(b, l, D_SSD) * g_norm.astype(f32)).astype(z.dtype)

    out_l = gated_norm(yl, zl)
    out_c = gated_norm(yc, zc) if need_ctx else None
    return out_l, out_c


def s5_discretise(lam_re, lam_im, log_step, b_re, b_im):
    f32 = jnp.float32
    lr = lam_re.astype(f32)
    li = lam_im.astype(f32)
    step = jnp.exp(log_step.astype(f32))[:, None]
    mag = jnp.exp(lr * step)
    ar = mag * jnp.cos(li * step)
    ai = mag * jnp.sin(li * step)
    den = lr * lr + li * li
    fr = ((ar - 1.0) * lr + ai * li) / den
    fi = (ai * lr - (ar - 1.0) * li) / den
    br = b_re.astype(f32)
    bi = b_im.astype(f32)
    bbr = fr[..., None] * br - fi[..., None] * bi
    bbi = fr[..., None] * bi + fi[..., None] * br
    return ar, ai, bbr, bbi


def s5_scan(u, ar, ai, bbr, bbi, h0r, h0i):
    l = u.shape[1]
    xr = jnp.einsum('blgk,gpk->blgp', u, bbr)
    xi = jnp.einsum('blgk,gpk->blgp', u, bbi)
    xr = xr.at[:, 0].add(ar * h0r - ai * h0i)
    xi = xi.at[:, 0].add(ar * h0i + ai * h0r)
    a_r = jnp.broadcast_to(ar, (1, l) + ar.shape)
    a_i = jnp.broadcast_to(ai, (1, l) + ai.shape)

    def combine(e1, e2):
        a1r, a1i, b1r, b1i = e1
        a2r, a2i, b2r, b2i = e2
        return (a2r * a1r - a2i * a1i, a2r * a1i + a2i * a1r,
                a2r * b1r - a2i * b1i + b2r, a2r * b1i + a2i * b1r + b2i)

    _, _, hr, hi = lax.associative_scan(combine, (a_r, a_i, xr, xi), axis=1)
    return hr, hi


def s5_readout(hr, hi, c_re, c_im):
    b, l = hr.shape[:2]
    y = (jnp.einsum('blgp,gkp->blgk', hr, c_re.astype(jnp.float32))
         - jnp.einsum('blgp,gkp->blgk', hi, c_im.astype(jnp.float32)))
    return y.reshape(b, l, D_S5)


def s5_branch(ul, gl, uc, gc, lam_re, lam_im, log_step, b_re, b_im, c_re, c_im, d_skip,
              w_glu, b_glu, need_ctx):
    f32 = jnp.float32
    b = ul.shape[0]

    def grouped(u):
        return u.astype(f32).reshape(b, u.shape[1], S5_GROUPS, S5_GROUP)

    ulg = grouped(ul)
    ucg = grouped(uc)
    d32 = d_skip.astype(f32)
    yl = d32 * ul.astype(f32)
    yc = d32 * uc.astype(f32) if need_ctx else None
    h0 = jnp.zeros((b, S5_GROUPS, S5_STATE), f32)
    for d in range(2):
        rev = d == 1
        ar, ai, bbr, bbi = s5_discretise(lam_re[d], lam_im[d], log_step[d], b_re[d], b_im[d])
        hcr, hci = s5_scan(maybe_flip(ucg, rev), ar, ai, bbr, bbi, h0, h0)
        hlr, hli = s5_scan(maybe_flip(ulg, rev), ar, ai, bbr, bbi, hcr[:, -1], hci[:, -1])
        yl = yl + maybe_flip(s5_readout(hlr, hli, c_re[d], c_im[d]), rev)
        if need_ctx:
            yc = yc + maybe_flip(s5_readout(hcr, hci, c_re[d], c_im[d]), rev)

    def glu(y, g, dtype):
        v = jax.nn.gelu(y)
        out = v * jax.nn.sigmoid(v @ w_glu.astype(f32) + b_glu.astype(f32))
        return (out * jax.nn.silu(g.astype(f32))).astype(dtype)

    out_l = glu(yl, gl, ul.dtype)
    out_c = glu(yc, gc, uc.dtype) if need_ctx else None
    return out_l, out_c


def fnet_branch(u, g, w, bias):
    b, l, _ = u.shape
    spec = jnp.fft.fft2(u.astype(jnp.float32).reshape(b, l, FNET_HEADS, FNET_HEAD_DIM),
                        axes=(1, 3), norm='ortho').real
    mixed = spec.reshape(b, l, D_FNET).astype(u.dtype) @ w + bias
    return mixed * jax.nn.silu(g)


def hybrid_mixer(hl, hc, w_in, conv_w, conv_b, dt_bias, a_log, d_ssd, g_ssd_norm,
                 lam_re, lam_im, log_step, b_re, b_im, c_re, c_im, s5_d, w_glu, b_glu,
                 fnet_w, fnet_b, w_out, need_ctx):
    zl, xbcl, dtl, usl, gsl, ufl, gfl = jnp.split(hl @ w_in, SPLIT_POINTS, axis=-1)
    zc, xbcc, dtc, usc, gsc, ufc, gfc = jnp.split(hc @ w_in, SPLIT_POINTS, axis=-1)
    ssd_l, ssd_c = ssd_branch(zl, xbcl, dtl, zc, xbcc, dtc, conv_w, conv_b, dt_bias, a_log,
                              d_ssd, g_ssd_norm, need_ctx)
    s5_l, s5_c = s5_branch(usl, gsl, usc, gsc, lam_re, lam_im, log_step, b_re, b_im, c_re, c_im,
                           s5_d, w_glu, b_glu, need_ctx)
    out_l = jnp.concatenate([ssd_l, s5_l, fnet_branch(ufl, gfl, fnet_w, fnet_b)], axis=-1) @ w_out
    if not need_ctx:
        return out_l, None
    out_c = jnp.concatenate([ssd_c, s5_c, fnet_branch(ufc, gfc, fnet_w, fnet_b)], axis=-1) @ w_out
    return out_l, out_c


def setup_inputs(seed: int = 0) -> dict:
    key = jax.random.key(seed)
    ks = jax.random.split(key, 32)
    f32 = jnp.float32
    L = DEPTH

    def nrm(k, shape, scale):
        return jax.random.normal(k, shape, f32) * scale

    def log_uniform(k, shape, lo, hi):
        return jax.random.uniform(k, shape, f32, np.log(lo), np.log(hi))

    dt0 = jnp.exp(log_uniform(ks[11], (L, 2, SSD_HEADS), 1e-3, 1e-1))
    lam_im = jnp.broadcast_to(jnp.pi * jnp.arange(S5_STATE, dtype=f32), (L, 2, S5_GROUPS, S5_STATE))
    return {
        'x': nrm(ks[0], (BATCH, SEQ, D_MODEL), 1.0),
        'c': nrm(ks[1], (BATCH, D_MODEL), 1.0),
        'ctx': nrm(ks[2], (BATCH, CTX_LEN, D_MODEL), 1.0),
        'c_ctx': nrm(ks[3], (D_MODEL,), 1.0),
        'w_mod': nrm(ks[4], (L, D_MODEL, 3 * D_MODEL), 0.5 * D_MODEL ** -0.5),
        'b_mod': nrm(ks[5], (L, 3 * D_MODEL), 0.02),
        'g_pre': 1.0 + nrm(ks[6], (L, D_MODEL), 0.02),
        'g_post': 1.0 + nrm(ks[7], (L, D_MODEL), 0.02),
        'w_in': nrm(ks[8], (L, D_MODEL, D_IN_PROJ), D_MODEL ** -0.5),
        'conv_w': nrm(ks[9], (L, CONV_K, CONV_K, D_CONV_CH), 1.0 / CONV_K),
        'conv_b': nrm(ks[10], (L, D_CONV_CH), 0.02),
        'dt_bias': dt0 + jnp.log(-jnp.expm1(-dt0)),
        'a_log': jnp.log(jax.random.uniform(ks[12], (L, 2, SSD_HEADS), f32, 1.0, 16.0)),
        'd_ssd': 1.0 + nrm(ks[13], (L, SSD_HEADS), 0.02),
        'g_ssd_norm': 1.0 + nrm(ks[14], (L, D_SSD), 0.02),
        's5_lambda_re': -0.5 + nrm(ks[15], (L, 2, S5_GROUPS, S5_STATE), 0.01),
        's5_lambda_im': lam_im,
        's5_log_step': log_uniform(ks[16], (L, 2, S5_GROUPS), 1e-3, 1e-1),
        's5_b_re': nrm(ks[17], (L, 2, S5_GROUPS, S5_STATE, S5_GROUP), (2.0 * S5_GROUP) ** -0.5),
        's5_b_im': nrm(ks[18], (L, 2, S5_GROUPS, S5_STATE, S5_GROUP), (2.0 * S5_GROUP) ** -0.5),
        's5_c_re': nrm(ks[19], (L, 2, S5_GROUPS, S5_GROUP, S5_STATE), (2.0 * S5_STATE) ** -0.5),
        's5_c_im': nrm(ks[20], (L, 2, S5_GROUPS, S5_GROUP, S5_STATE), (2.0 * S5_STATE) ** -0.5),
        's5_d': nrm(ks[21], (L, D_S5), 1.0),
        's5_w_glu': nrm(ks[22], (L, D_S5, D_S5), D_S5 ** -0.5),
        's5_b_glu': nrm(ks[23], (L, D_S5), 0.02),
        'fnet_w': nrm(ks[24], (L, D_FNET, D_FNET), D_FNET ** -0.5),
        'fnet_b': nrm(ks[25], (L, D_FNET), 0.02),
        'w_out': nrm(ks[26], (L, D_MIX, D_MODEL), D_MIX ** -0.5),
    }


def reference(x, c, ctx, c_ctx, w_mod, b_mod, g_pre, g_post, w_in, conv_w, conv_b, dt_bias, a_log,
              d_ssd, g_ssd_norm, s5_lambda_re, s5_lambda_im, s5_log_step, s5_b_re, s5_b_im,
              s5_c_re, s5_c_im, s5_d, s5_w_glu, s5_b_glu, fnet_w, fnet_b, w_out):
    xl, xc = x, ctx
    for i in range(DEPTH):
        need_ctx = i < DEPTH - 1
        mod_l = jax.nn.silu(c) @ w_mod[i] + b_mod[i]
        mod_c = jax.nn.silu(c_ctx) @ w_mod[i] + b_mod[i]
        shift_l, scale_l, gate_l = jnp.split(mod_l[:, None, :], 3, axis=-1)
        shift_c, scale_c, gate_c = jnp.split(mod_c, 3, axis=-1)
        hl = rmsnorm(xl, g_pre[i]) * (1.0 + scale_l) + shift_l
        hc = rmsnorm(xc, g_pre[i]) * (1.0 + scale_c) + shift_c
        yl, yc = hybrid_mixer(hl, hc, w_in[i], conv_w[i], conv_b[i], dt_bias[i], a_log[i], d_ssd[i],
                              g_ssd_norm[i], s5_lambda_re[i], s5_lambda_im[i], s5_log_step[i],
                              s5_b_re[i], s5_b_im[i], s5_c_re[i], s5_c_im[i], s5_d[i], s5_w_glu[i],
                              s5_b_glu[i], fnet_w[i], fnet_b[i], w_out[i], need_ctx)
        xl = xl + gate_l * rmsnorm(yl, g_post[i])
        if need_ctx:
            xc = xc + gate_c * rmsnorm(yc, g_post[i])
    return xl
```

```cpp
#include <hip/hip_runtime.h>
#include <hip/hip_bf16.h>
#include <hip/hip_cooperative_groups.h>
#include <cstdio>
namespace cg = cooperative_groups;

#ifndef MULTI_LAUNCH
#define MULTI_LAUNCH 0
#endif

typedef unsigned short u16;
using bf16x8 = __attribute__((ext_vector_type(8))) short;
using f32x4 = __attribute__((ext_vector_type(4))) float;

#define NLAT 16384
#define NCTX 1024
#define NTOK 17408
#define DM 1024
#define DINP 4736
#define DIN 4640
#define NLAYER 4
#define EPSV 1e-6f

constexpr size_t al256(size_t x) { return (x + 255) & ~size_t(255); }
constexpr size_t OFF_XC = 0;
constexpr size_t OFF_RS = OFF_XC + al256((size_t)1024 * 1024 * 4);
constexpr size_t OFF_MOD = OFF_RS + al256((size_t)NTOK * 4);
constexpr size_t OFF_DT = OFF_MOD + al256((size_t)4 * 5 * 3072 * 4);
constexpr size_t OFF_SSQV = OFF_DT + al256((size_t)NTOK * 32 * 4);
constexpr size_t OFF_SSQY = OFF_SSQV + al256((size_t)NTOK * 16 * 4);
constexpr size_t OFF_CDEC = OFF_SSQY + al256((size_t)NTOK * 16 * 4);
constexpr size_t OFF_TAB = OFF_CDEC + al256((size_t)136 * 16 * 2 * 4);
constexpr int TAB_F64C = 0, TAB_F64S = 4096, TAB_F4C = 8192, TAB_F4S = 8208, TAB_TWC = 8224, TAB_TWS = 12320, TAB_N = 16416;
constexpr size_t OFF_KTAB = OFF_TAB + al256((size_t)TAB_N * 4);
constexpr size_t OFF_Z = OFF_KTAB + al256((size_t)32 * 8192 * 4);
constexpr size_t OFF_S5U = OFF_Z + al256((size_t)NTOK * 1024 * 2);
constexpr size_t OFF_S5G = OFF_S5U + al256((size_t)NTOK * 512 * 2);
constexpr size_t OFF_FU = OFF_S5G + al256((size_t)NTOK * 512 * 2);
constexpr size_t OFF_FIM = OFF_FU + (size_t)NTOK * 512 * 2;
constexpr size_t OFF_FG = OFF_FIM + al256((size_t)NTOK * 512 * 2);
constexpr size_t OFF_S5ST = OFF_FG + al256((size_t)NTOK * 512 * 2);
constexpr size_t OFF_WOUTT = OFF_S5ST + al256((size_t)1088 * 32 * 256 * 2);
constexpr size_t OFF_GLUT = OFF_WOUTT + al256((size_t)1024 * 2048 * 2);
constexpr size_t OFF_WCST = OFF_GLUT + al256((size_t)512 * 512 * 2);
constexpr size_t OFF_S5M1 = OFF_WCST + al256((size_t)512 * 1024 * 2);
constexpr size_t OFF_S5TH = OFF_S5M1 + al256((size_t)32 * 256 * 256 * 2);
constexpr size_t OFF_R3 = OFF_S5TH + al256((size_t)32 * 256 * 512 * 2);
constexpr size_t OFF_XT = OFF_R3;
constexpr size_t OFF_BN = OFF_XT + (size_t)136 * 1024 * 128 * 2;
constexpr size_t OFF_CN = OFF_BN + (size_t)NTOK * 256 * 2;
constexpr size_t OFF_WINT = OFF_R3;
constexpr size_t OFF_R4 = OFF_CN + (size_t)NTOK * 256 * 2;
constexpr size_t OFF_ST = OFF_R4;
constexpr size_t OFF_RAW = OFF_R4;
constexpr size_t WS_NEED = OFF_R4 + (size_t)136 * 16 * 2 * 8192 * 2;

#define SMEM_BYTES 57344

struct Params {
  const float *x, *c, *ctx, *c_ctx, *w_mod, *b_mod, *g_pre, *g_post, *w_in, *conv_w, *conv_b, *dt_bias, *a_log,
      *d_ssd, *g_ssd_norm, *lam_re, *lam_im, *log_step, *b_re, *b_im, *c_re, *c_im, *s5_d, *w_glu, *b_glu, *fnet_w,
      *fnet_b, *w_out;
  float* out;
  char* ws;
};

__device__ __forceinline__ u16 f2bf(float f) {
  unsigned u = __float_as_uint(f);
  u += 0x7fffu + ((u >> 16) & 1u);
  return (u16)(u >> 16);
}
__device__ __forceinline__ float bf2f(u16 h) { return __uint_as_float(((unsigned)h) << 16); }
__device__ __forceinline__ unsigned pack2(float a, float b) { return (unsigned)f2bf(a) | ((unsigned)f2bf(b) << 16); }
__device__ __forceinline__ float lo16(unsigned u) { return __uint_as_float(u << 16); }
__device__ __forceinline__ float hi16(unsigned u) { return __uint_as_float(u & 0xffff0000u); }
__device__ __forceinline__ float silu_f(float x) { return x / (1.f + __expf(-x)); }
__device__ __forceinline__ float sigmoid_f(float x) { return 1.f / (1.f + __expf(-x)); }
__device__ __forceinline__ float gelu_tanh(float x) {
  float u = 0.7978845608028654f * (x + 0.044715f * x * x * x);
  return x / (1.f + __expf(-2.f * u));
}
__device__ __forceinline__ float softplus_f(float x) { return x > 20.f ? x : log1pf(expf(x)); }
__device__ __forceinline__ int get_tid() {
  int t = threadIdx.x;
  asm volatile("" : "+v"(t));
  return t;
}
__device__ __forceinline__ bf16x8 as_frag(uint4 v) {
  union { uint4 u; bf16x8 f; } cv;
  cv.u = v;
  return cv.f;
}
__device__ __forceinline__ float wave_sum(float v) {
#pragma unroll
  for (int o = 32; o > 0; o >>= 1) v += __shfl_xor(v, o, 64);
  return v;
}
__device__ __forceinline__ float sum16(float v) {
#pragma unroll
  for (int o = 8; o > 0; o >>= 1) v += __shfl_xor(v, o, 64);
  return v;
}

__device__ __forceinline__ const float* res_src(const Params& p, int l, int r) {
  if (l == 0) return (r < NLAT) ? p.x + (size_t)r * DM : p.ctx + (size_t)(r - NLAT) * DM;
  return (r < NLAT) ? p.out + (size_t)r * DM : (const float*)(p.ws + OFF_XC) + (size_t)(r - NLAT) * DM;
}

template <int MODE>
__device__ __forceinline__ uint4 gemm_loadA(const Params& p, int l, int r, int k) {
  char* ws = p.ws;
  if (MODE == 0) {
    const float* src = res_src(p, l, r);
    int b5 = (r < NLAT) ? (r >> 12) : 4;
    const float* mv = (const float*)(ws + OFF_MOD) + (size_t)(l * 5 + b5) * 3072;
    float rsv = ((const float*)(ws + OFF_RS))[r];
    float4 x0 = *(const float4*)(src + k), x1 = *(const float4*)(src + k + 4);
    float4 a0 = *(const float4*)(mv + 1024 + k), a1 = *(const float4*)(mv + 1024 + k + 4);
    float4 s0 = *(const float4*)(mv + k), s1 = *(const float4*)(mv + k + 4);
    uint4 o;
    o.x = pack2(x0.x * rsv * a0.x + s0.x, x0.y * rsv * a0.y + s0.y);
    o.y = pack2(x0.z * rsv * a0.z + s0.z, x0.w * rsv * a0.w + s0.w);
    o.z = pack2(x1.x * rsv * a1.x + s1.x, x1.y * rsv * a1.y + s1.y);
    o.w = pack2(x1.z * rsv * a1.z + s1.z, x1.w * rsv * a1.w + s1.w);
    return o;
  } else if (MODE == 1) {
    if (k < 1024) {
      uint4 v = *(const uint4*)((const u16*)(ws + OFF_Z) + (size_t)r * 1024 + k);
      const float* sq = (const float*)(ws + OFF_SSQV) + (size_t)r * 16 + (k >> 9) * 8;
      float4 q0 = *(const float4*)sq, q1 = *(const float4*)(sq + 4);
      float sc = rsqrtf((q0.x + q0.y + q0.z + q0.w + q1.x + q1.y + q1.z + q1.w) * (1.f / 512.f) + EPSV);
      const float* gn = p.g_ssd_norm + l * 1024 + k;
      float4 g0 = *(const float4*)gn, g1 = *(const float4*)(gn + 4);
      uint4 o;
      o.x = pack2(lo16(v.x) * sc * g0.x, hi16(v.x) * sc * g0.y);
      o.y = pack2(lo16(v.y) * sc * g0.z, hi16(v.y) * sc * g0.w);
      o.z = pack2(lo16(v.z) * sc * g1.x, hi16(v.z) * sc * g1.y);
      o.w = pack2(lo16(v.w) * sc * g1.z, hi16(v.w) * sc * g1.w);
      return o;
    } else if (k < 1536) {
      return *(const uint4*)((const u16*)(ws + OFF_S5G) + (size_t)r * 512 + (k - 1024));
    } else {
      return *(const uint4*)((const u16*)(ws + OFF_FG) + (size_t)r * 512 + (k - 1536));
    }
  } else if (MODE == 2) {
    if (k < 512) return *(const uint4*)((const u16*)(ws + OFF_FU) + (size_t)r * 512 + k);
    return *(const uint4*)((const u16*)(ws + OFF_FIM) + (size_t)r * 512 + (k - 512));
  } else {
    return *(const uint4*)((const u16*)(ws + OFF_S5U) + ((size_t)(k >> 4) * NTOK + r) * 16 + (k & 15));
  }
}

template <int MODE>
__device__ __forceinline__ void gemm_epi(const Params& p, int l, int row0, int col0, int fr, const f32x4& a, int slot) {
  char* ws = p.ws;
  int col = col0 + fr;
  if (MODE == 0) {
    if (col0 < 1024) {
      u16* z = (u16*)(ws + OFF_Z);
#pragma unroll
      for (int j = 0; j < 4; j++) z[(size_t)(row0 + j) * 1024 + col] = f2bf(a[j]);
    } else if (col0 < 2560) {
      u16* raw = (u16*)(ws + OFF_RAW);
#pragma unroll
      for (int j = 0; j < 4; j++) raw[(size_t)(row0 + j) * 1536 + (col - 1024)] = f2bf(a[j]);
    } else if (col0 < 3072) {
      u16* u = (u16*)(ws + OFF_S5U);
      int g = (col0 - 2560) >> 4;
#pragma unroll
      for (int j = 0; j < 4; j++) u[((size_t)g * NTOK + row0 + j) * 16 + fr] = f2bf(a[j]);
    } else if (col0 < 3584) {
      u16* d = (u16*)(ws + OFF_S5G);
#pragma unroll
      for (int j = 0; j < 4; j++) d[(size_t)(row0 + j) * 512 + (col - 3072)] = f2bf(a[j]);
    } else if (col0 < 4096) {
      u16* d = (u16*)(ws + OFF_FU);
#pragma unroll
      for (int j = 0; j < 4; j++) d[(size_t)(row0 + j) * 512 + (col - 3584)] = f2bf(a[j]);
    } else if (col0 < 4608) {
      u16* d = (u16*)(ws + OFF_FG);
#pragma unroll
      for (int j = 0; j < 4; j++) d[(size_t)(row0 + j) * 512 + (col - 4096)] = f2bf(a[j]);
    } else if (col0 < 4640) {
      float* d = (float*)(ws + OFF_DT);
      float bias = p.dt_bias[l * 32 + (col - 4608)];
#pragma unroll
      for (int j = 0; j < 4; j++) d[(size_t)(row0 + j) * 32 + (col - 4608)] = softplus_f(a[j] + bias);
    }
  } else if (MODE == 1) {
    u16* y = (u16*)(ws + OFF_FU);
#pragma unroll
    for (int j = 0; j < 4; j++) y[(size_t)(row0 + j) * 1024 + col] = f2bf(a[j]);
  } else if (MODE == 2) {
    u16* fg = (u16*)(ws + OFF_FG);
    float bias = p.fnet_b[l * 512 + col];
#pragma unroll
    for (int j = 0; j < 4; j++) {
      int r = row0 + j, rr;
      if (r < NLAT) {
        int pos = r & 4095;
        rr = (r & ~4095) + (pos >> 6) + 64 * (pos & 63);
      } else {
        int q = r - NLAT;
        int pos = q & 255;
        rr = NLAT + (q & ~255) + (pos >> 6) + 4 * (pos & 63);
      }
      size_t idx = (size_t)rr * 512 + col;
      float g = bf2f(fg[idx]);
      fg[idx] = f2bf((a[j] + bias) * silu_f(g));
    }
  } else {
    u16* sg = (u16*)(ws + OFF_S5G);
    const u16* sv = (const u16*)(ws + OFF_S5U);
    float bias = p.b_glu[l * 512 + col];
#pragma unroll
    for (int j = 0; j < 4; j++) {
      int r = row0 + j;
      float v = bf2f(sv[((size_t)(col >> 4) * NTOK + r) * 16 + (col & 15)]);
      size_t idx = (size_t)r * 512 + col;
      float g = bf2f(sg[idx]);
      sg[idx] = f2bf(v * sigmoid_f(a[j] + bias) * silu_f(g));
    }
  }
}

template <int MODE>
__device__ __forceinline__ void gemm_tile(const Params& p, int l, int mt, int nt, char* smem) {
  constexpr int K = (MODE == 0) ? 1024 : (MODE == 1) ? 2048 : (MODE == 2) ? 1024 : 512;
  constexpr int NKT = K / 32;
  const u16* Bt = (const u16*)(p.ws + ((MODE == 0) ? OFF_WINT : (MODE == 1) ? OFF_WOUTT : (MODE == 2) ? OFF_WCST : OFF_GLUT));
  u16* sA = (u16*)smem;
  u16* sB = sA + 2 * 128 * 32;
  const int tid = get_tid(), lane = tid & 63, w = tid >> 6, wm = w >> 1, wn = w & 1;
  const int fr = lane & 15, fq = lane >> 4;
  const int lr0 = tid >> 2, kc = tid & 3;
  const int rowA0 = mt * 128 + lr0, rowA1 = rowA0 + 64;
  const u16* bp0 = Bt + (size_t)(nt * 128 + lr0) * K + kc * 8;
  const u16* bp1 = bp0 + (size_t)64 * K;

  f32x4 acc[4][4];
#pragma unroll
  for (int i = 0; i < 4; i++)
#pragma unroll
    for (int j = 0; j < 4; j++) acc[i][j] = f32x4{0.f, 0.f, 0.f, 0.f};

  uint4 ra0 = gemm_loadA<MODE>(p, l, rowA0, kc * 8);
  uint4 ra1 = gemm_loadA<MODE>(p, l, rowA1, kc * 8);
  uint4 rb0 = *(const uint4*)bp0;
  uint4 rb1 = *(const uint4*)bp1;
  __syncthreads();
  *(uint4*)(sA + tid * 8) = ra0;
  *(uint4*)(sA + (tid + 256) * 8) = ra1;
  *(uint4*)(sB + tid * 8) = rb0;
  *(uint4*)(sB + (tid + 256) * 8) = rb1;
  __syncthreads();

  for (int kt = 0; kt < NKT; kt++) {
    const int cur = kt & 1;
    if (kt + 1 < NKT) {
      int k = (kt + 1) * 32 + kc * 8;
      ra0 = gemm_loadA<MODE>(p, l, rowA0, k);
      ra1 = gemm_loadA<MODE>(p, l, rowA1, k);
      rb0 = *(const uint4*)(bp0 + (kt + 1) * 32);
      rb1 = *(const uint4*)(bp1 + (kt + 1) * 32);
    }
    const u16* cA = sA + cur * 4096;
    const u16* cB = sB + cur * 4096;
    bf16x8 af[4], bfr[4];
#pragma unroll
    for (int i = 0; i < 4; i++) af[i] = *(const bf16x8*)(cA + (wm * 64 + i * 16 + fr) * 32 + fq * 8);
#pragma unroll
    for (int i = 0; i < 4; i++) bfr[i] = *(const bf16x8*)(cB + (wn * 64 + i * 16 + fr) * 32 + fq * 8);
#pragma unroll
    for (int i = 0; i < 4; i++)
#pragma unroll
      for (int j = 0; j < 4; j++) acc[i][j] = __builtin_amdgcn_mfma_f32_16x16x32_bf16(af[i], bfr[j], acc[i][j], 0, 0, 0);
    if (kt + 1 < NKT) {
      u16* nA = sA + (cur ^ 1) * 4096;
      u16* nB = sB + (cur ^ 1) * 4096;
      *(uint4*)(nA + tid * 8) = ra0;
      *(uint4*)(nA + (tid + 256) * 8) = ra1;
      *(uint4*)(nB + tid * 8) = rb0;
      *(uint4*)(nB + (tid + 256) * 8) = rb1;
    }
    __syncthreads();
  }
#pragma unroll
  for (int i = 0; i < 4; i++) {
    int row0 = mt * 128 + wm * 64 + i * 16 + fq * 4;
#pragma unroll
    for (int j = 0; j < 4; j++) {
      int col0 = nt * 128 + wn * 64 + j * 16;
      gemm_epi<MODE>(p, l, row0, col0, fr, acc[i][j], 0);
    }
    if (MODE == 1) {
      float* sq = (float*)(p.ws + OFF_SSQY);
#pragma unroll
      for (int jj = 0; jj < 4; jj++) {
        float s = 0.f;
#pragma unroll
        for (int j = 0; j < 4; j++) s += acc[i][j][jj] * acc[i][j][jj];
        s = sum16(s);
        if (fr == 0) sq[(size_t)(row0 + jj) * 16 + nt * 2 + wn] = s;
      }
    }
  }
}

__device__ __forceinline__ void mod_task(const Params& p, int task, char* smem) {
  float* sc = (float*)smem;
  const int tid = get_tid();
  const int l = task / 12, cb = task % 12;
  __syncthreads();
  for (int i = tid; i < 5 * 1024; i += 256) {
    int b = i >> 10, k = i & 1023;
    float v = (b < 4) ? p.c[b * 1024 + k] : p.c_ctx[k];
    sc[i] = silu_f(v);
  }
  __syncthreads();
  const int col = cb * 256 + tid;
  const float* wp = p.w_mod + (size_t)l * 1024 * 3072 + col;
  float a0 = 0, a1 = 0, a2 = 0, a3 = 0, a4 = 0;
#pragma unroll 8
  for (int k = 0; k < 1024; k++) {
    float wv = wp[(size_t)k * 3072];
    a0 += sc[k] * wv;
    a1 += sc[1024 + k] * wv;
    a2 += sc[2048 + k] * wv;
    a3 += sc[3072 + k] * wv;
    a4 += sc[4096 + k] * wv;
  }
  float bias = p.b_mod[l * 3072 + col];
  float vals[5] = {a0 + bias, a1 + bias, a2 + bias, a3 + bias, a4 + bias};
  float* mv = (float*)(p.ws + OFF_MOD);
  float gp = (col >= 1024 && col < 2048) ? p.g_pre[l * 1024 + col - 1024] : 0.f;
#pragma unroll
  for (int b = 0; b < 5; b++) {
    float v = vals[b];
    if (col >= 1024 && col < 2048) v = gp * (1.f + v);
    mv[(size_t)(l * 5 + b) * 3072 + col] = v;
  }
}

__device__ __forceinline__ void tables_task(const Params& p) {
  float* tab = (float*)(p.ws + OFF_TAB);
  for (int i = get_tid(); i < 4096; i += 256) {
    int n1 = i >> 6, k1 = i & 63;
    int m = (n1 * k1) & 63;
    float s, c;
    sincospif(2.f * (float)m / 64.f, &s, &c);
    tab[TAB_F64C + i] = c;
    tab[TAB_F64S + i] = s;
    sincospif(2.f * (float)i / 4096.f, &s, &c);
    tab[TAB_TWC + i] = c;
    tab[TAB_TWS + i] = s;
    if (i < 16) {
      int m4 = ((i >> 2) * (i & 3)) & 3;
      sincospif(2.f * (float)m4 / 4.f, &s, &c);
      tab[TAB_F4C + i] = c;
      tab[TAB_F4S + i] = s;
    }
  }
}

__device__ __forceinline__ void rowstat_task(const Params& p, int task) {
  const int lane = get_tid() & 63, w = get_tid() >> 6;
  const int r = task * 4 + w;
  const float* src = res_src(p, 0, r) + lane * 16;
  float s = 0.f;
#pragma unroll
  for (int i = 0; i < 4; i++) {
    float4 v = *(const float4*)(src + i * 4);
    s += v.x * v.x + v.y * v.y + v.z * v.z + v.w * v.w;
  }
  s = wave_sum(s);
  if (lane == 0) ((float*)(p.ws + OFF_RS))[r] = rsqrtf(s * (1.f / 1024.f) + EPSV);
}

__device__ __forceinline__ void transpose_tile(const float* src, int src_ld, int src_col0, int nvalid, u16* dst, int dst_ld, int n0, int k0,
                               char* smem) {
  float* sT = (float*)smem;
  const int tid = get_tid();
  __syncthreads();
  {
    int nn = tid & 63, kq = tid >> 6;
#pragma unroll 4
    for (int i = 0; i < 16; i++) {
      int kk = kq + 4 * i;
      float v = (nn < nvalid) ? src[(size_t)(k0 + kk) * src_ld + src_col0 + nn] : 0.f;
      sT[nn * 65 + kk] = v;
    }
  }
  __syncthreads();
#pragma unroll
  for (int i = 0; i < 2; i++) {
    int id = tid + 256 * i;
    int nn = id >> 3, kc = id & 7;
    const float* s = sT + nn * 65 + kc * 8;
    uint4 o;
    o.x = pack2(s[0], s[1]);
    o.y = pack2(s[2], s[3]);
    o.z = pack2(s[4], s[5]);
    o.w = pack2(s[6], s[7]);
    *(uint4*)(dst + (size_t)(n0 + nn) * dst_ld + k0 + kc * 8) = o;
  }
}

__device__ __forceinline__ void wcs_task(const Params& p, int l, int task, char* smem) {
  float* sC = (float*)smem;
  const int tid = get_tid();
  const int h = task >> 7, c = task & 127;
  __syncthreads();
  if (tid < 128) {
    float s, co;
    sincospif(2.f * (float)((tid * c) & 127) / 128.f, &s, &co);
    sC[tid] = co;
    sC[128 + tid] = s;
  }
  __syncthreads();
  const float* wp = p.fnet_w + (size_t)l * 512 * 512 + (size_t)(h * 128) * 512;
  float r0 = 0, i0 = 0, r1 = 0, i1 = 0;
#pragma unroll 4
  for (int m = 0; m < 128; m++) {
    float w0 = wp[(size_t)m * 512 + tid], w1 = wp[(size_t)m * 512 + tid + 256];
    float co = sC[m], si = sC[128 + m];
    r0 += co * w0;
    i0 += si * w0;
    r1 += co * w1;
    i1 += si * w1;
  }
  const float sc = 0.08838834764831845f;
  u16* d = (u16*)(p.ws + OFF_WCST);
  d[(size_t)tid * 1024 + h * 128 + c] = f2bf(r0 * sc);
  d[(size_t)tid * 1024 + 512 + h * 128 + c] = f2bf(i0 * sc);
  d[(size_t)(tid + 256) * 1024 + h * 128 + c] = f2bf(r1 * sc);
  d[(size_t)(tid + 256) * 1024 + 512 + h * 128 + c] = f2bf(i1 * sc);
}

__device__ __forceinline__ void s5tab_task(const Params& p, int l, int g, char* smem) {
  float2* sAp = (float2*)smem;
  float2* sBb = sAp + 2 * 17 * 64;
  float2* sCc = sBb + 2 * 64 * 16;
  const int tid = get_tid();
  __syncthreads();
  for (int e = tid; e < 2 * 17 * 64; e += 256) {
    int d = e / (17 * 64), tau = (e / 64) % 17, pp = e & 63;
    int pi = ((l * 2 + d) * 32 + g) * 64 + pp;
    float step = expf(p.log_step[(l * 2 + d) * 32 + g]);
    float lr = p.lam_re[pi], li = p.lam_im[pi];
    float mag = expf(lr * step * (float)tau);
    float ang = li * step * (float)tau;
    sAp[e] = make_float2(mag * cosf(ang), mag * sinf(ang));
  }
  for (int e = tid; e < 2 * 64 * 16; e += 256) {
    int d = e >> 10, pp = (e >> 4) & 63, kk = e & 15;
    int pi = ((l * 2 + d) * 32 + g) * 64 + pp;
    float step = expf(p.log_step[(l * 2 + d) * 32 + g]);
    float lr = p.lam_re[pi], li = p.lam_im[pi];
    float mag = expf(lr * step);
    float ar = mag * cosf(li * step), ai = mag * sinf(li * step);
    float den = lr * lr + li * li;
    float fr_ = ((ar - 1.f) * lr + ai * li) / den;
    float fi_ = (ai * lr - (ar - 1.f) * li) / den;
    float br = p.b_re[(size_t)pi * 16 + kk], bi = p.b_im[(size_t)pi * 16 + kk];
    sBb[e] = make_float2(fr_ * br - fi_ * bi, fr_ * bi + fi_ * br);
  }
  for (int e = tid; e < 2 * 16 * 64; e += 256) {
    int d = e >> 10, kk = (e >> 6) & 15, pp = e & 63;
    size_t ci = ((size_t)((l * 2 + d) * 32 + g) * 16 + kk) * 64 + pp;
    sCc[e] = make_float2(p.c_re[ci], p.c_im[ci]);
  }
  __syncthreads();
  float* kt = (float*)(p.ws + OFF_KTAB) + (size_t)g * 8192;
  for (int e = tid; e < 8192; e += 256) {
    int d = e >> 12, tau = (e >> 8) & 15, k = (e >> 4) & 15, k2 = e & 15;
    float s = 0.f;
    for (int pp = 0; pp < 64; pp++) {
      float2 cc = sCc[(d * 16 + k) * 64 + pp];
      float2 ap = sAp[(d * 17 + tau) * 64 + pp];
      float2 bb = sBb[(d * 64 + pp) * 16 + k2];
      float cr = cc.x * ap.x - cc.y * ap.y, ci = cc.x * ap.y + cc.y * ap.x;
      s += cr * bb.x - ci * bb.y;
    }
    kt[e] = s;
  }
  __syncthreads();
  u16* TH = (u16*)(p.ws + OFF_S5TH) + (size_t)g * 256 * 512;
  for (int e = tid; e < 256 * 512; e += 256) {
    int row = e >> 9, col = e & 511;
    int i = row >> 4, k = row & 15;
    float v;
    if (col < 256) {
      int j = col >> 4, k2 = col & 15;
      v = 0.f;
      if (j <= i) v += kt[(0 * 16 + (i - j)) * 256 + k * 16 + k2];
      if (j >= i) v += kt[(1 * 16 + (j - i)) * 256 + k * 16 + k2];
      if (i == j && k == k2) v += p.s5_d[l * 512 + g * 16 + k];
    } else {
      int q = col - 256;
      int d = q >> 7, ri = (q >> 6) & 1, pp = q & 63;
      int pw = (d == 0) ? (i + 1) : (16 - i);
      float2 cc = sCc[(d * 16 + k) * 64 + pp];
      float2 ap = sAp[(d * 17 + pw) * 64 + pp];
      float cr = cc.x * ap.x - cc.y * ap.y, ci = cc.x * ap.y + cc.y * ap.x;
      v = (ri == 0) ? cr : -ci;
    }
    TH[e] = f2bf(v);
  }
  u16* M1 = (u16*)(p.ws + OFF_S5M1) + (size_t)g * 256 * 256;
  for (int e = tid; e < 256 * 256; e += 256) {
    int row = e >> 8, col = e & 255;
    int d = row >> 7, ri = (row >> 6) & 1, pp = row & 63;
    int j = col >> 4, k2 = col & 15;
    int ex = (d == 0) ? (15 - j) : j;
    float2 ap = sAp[(d * 17 + ex) * 64 + pp];
    float2 bb = sBb[(d * 64 + pp) * 16 + k2];
    float v = (ri == 0) ? (ap.x * bb.x - ap.y * bb.y) : (ap.x * bb.y + ap.y * bb.x);
    M1[e] = f2bf(v);
  }
}

#define PREP_TASKS (32 + 1184 + 512 + 64 + 512)
__device__ __forceinline__ void prep_task(const Params& p, int l, int t, char* smem) {
  if (t < 32) {
    s5tab_task(p, l, t, smem);
    return;
  }
  t -= 32;
  if (t < 1184) {
    int nb = t / 16, kb = t % 16;
    int n0 = nb * 64;
    int src_col0, nvalid = 64;
    if (n0 < 2560) src_col0 = n0;
    else if (n0 < 4608) src_col0 = n0 + 32;
    else if (n0 < 4640) { src_col0 = n0 - 2048; nvalid = 32; }
    else { src_col0 = 0; nvalid = 0; }
    transpose_tile(p.w_in + (size_t)l * 1024 * DIN, DIN, src_col0, nvalid, (u16*)(p.ws + OFF_WINT), 1024, n0, kb * 64, smem);
    return;
  }
  t -= 1184;
  if (t < 512) {
    int nb = t / 32, kb = t % 32;
    transpose_tile(p.w_out + (size_t)l * 2048 * 1024, 1024, nb * 64, 64, (u16*)(p.ws + OFF_WOUTT), 2048, nb * 64, kb * 64, smem);
    return;
  }
  t -= 512;
  if (t < 64) {
    int nb = t / 8, kb = t % 8;
    transpose_tile(p.w_glu + (size_t)l * 512 * 512, 512, nb * 64, 64, (u16*)(p.ws + OFF_GLUT), 512, nb * 64, kb * 64, smem);
    return;
  }
  t -= 64;
  wcs_task(p, l, t, smem);
}

__device__ __forceinline__ void conv_task(const Params& p, int l, int task, char* smem) {
  float* sOut = (float*)smem;
  const int tid = get_tid();
  const int gc = task / 24, cb = task % 24;
  const int c = tid & 63, tq = tid >> 6;
  const int ch = cb * 64 + c;
  float wgt[9];
#pragma unroll
  for (int i = 0; i < 9; i++) wgt[i] = p.conv_w[(size_t)(l * 9 + i) * 1536 + ch];
  const float bias = p.conv_b[l * 1536 + ch];
  const u16* raw = (const u16*)(p.ws + OFF_RAW);
  __syncthreads();
  if (gc < 128) {
    const int b = gc >> 5;
    for (int i = 0; i < 32; i++) {
      int tl = tq * 32 + i;
      int t = (gc & 31) * 128 + tl;
      int row = t >> 6, col = t & 63;
      float a = bias;
#pragma unroll
      for (int di = 0; di < 3; di++) {
        int rr = row + di - 1;
        if (rr < 0 || rr > 63) continue;
#pragma unroll
        for (int dj = 0; dj < 3; dj++) {
          int cc = col + dj - 1;
          if (cc < 0 || cc > 63) continue;
          a += wgt[di * 3 + dj] * bf2f(raw[(size_t)(b * 4096 + rr * 64 + cc) * 1536 + ch]);
        }
      }
      sOut[tl * 65 + c] = silu_f(a);
    }
  } else {
    const int bc = gc - 128, b = bc >> 1;
    for (int i = 0; i < 32; i++) {
      int tl = tq * 32 + i;
      int t = (bc & 1) * 128 + tl;
      float a = bias;
#pragma unroll
      for (int dj = 0; dj < 3; dj++) {
        int tt = t + dj - 1;
        if (tt < 0 || tt > 255) continue;
        a += wgt[3 + dj] * bf2f(raw[(size_t)(NLAT + b * 256 + tt) * 1536 + ch]);
      }
      sOut[tl * 65 + c] = silu_f(a);
    }
  }
  __syncthreads();
  if (cb < 16) {
    u16* XT = (u16*)(p.ws + OFF_XT);
#pragma unroll
    for (int i = 0; i < 4; i++) {
      int id = tid + 256 * i;
      int chl = id >> 4, tc = id & 15;
      const float* s = sOut + (tc * 8) * 65 + chl;
      uint4 o;
      o.x = pack2(s[0], s[65]);
      o.y = pack2(s[130], s[195]);
      o.z = pack2(s[260], s[325]);
      o.w = pack2(s[390], s[455]);
      *(uint4*)(XT + ((size_t)gc * 1024 + cb * 64 + chl) * 128 + tc * 8) = o;
    }
  } else {
    u16* dst = (u16*)(p.ws + (cb < 20 ? OFF_BN : OFF_CN));
    const int c0 = (cb < 20 ? cb - 16 : cb - 20) * 64;
#pragma unroll
    for (int i = 0; i < 4; i++) {
      int id = tid + 256 * i;
      int tok = id >> 3, cc = id & 7;
      const float* s = sOut + tok * 65 + cc * 8;
      uint4 o;
      o.x = pack2(s[0], s[1]);
      o.y = pack2(s[2], s[3]);
      o.z = pack2(s[4], s[5]);
      o.w = pack2(s[6], s[7]);
      *(uint4*)(dst + (size_t)(gc * 128 + tok) * 256 + c0 + cc * 8) = o;
    }
  }
}

template <int N1>
__device__ __forceinline__ void fft1_task(const Params& p, int rowbase, int n2, int cb, char* smem) {
  float* sX = (float*)smem;
  const int tid = get_tid(), c = tid & 63;
  const int wq = __builtin_amdgcn_readfirstlane(tid >> 6);
  u16* fu = (u16*)(p.ws + OFF_FU);
  u16* fi = (u16*)(p.ws + OFF_FIM);
  const float* tab = (const float*)(p.ws + OFF_TAB);
  __syncthreads();
  for (int n1 = wq; n1 < N1; n1 += 4) sX[n1 * 64 + c] = bf2f(fu[(size_t)(rowbase + n1 * 64 + n2) * 512 + cb * 64 + c]);
  __syncthreads();
  constexpr int KPW = N1 / 4;
  const float* Fc = tab + (N1 == 64 ? TAB_F64C : TAB_F4C);
  const float* Fs = tab + (N1 == 64 ? TAB_F64S : TAB_F4S);
  float re[KPW], im[KPW];
#pragma unroll
  for (int i = 0; i < KPW; i++) re[i] = 0.f, im[i] = 0.f;
  for (int n1 = 0; n1 < N1; n1++) {
    float xv = sX[n1 * 64 + c];
#pragma unroll
    for (int i = 0; i < KPW; i++) {
      re[i] += xv * Fc[n1 * N1 + wq * KPW + i];
      im[i] -= xv * Fs[n1 * N1 + wq * KPW + i];
    }
  }
#pragma unroll
  for (int i = 0; i < KPW; i++) {
    int k1 = wq * KPW + i;
    int idx = (k1 * n2 * (64 / N1)) & 4095;
    float tc = tab[TAB_TWC + idx], ts = tab[TAB_TWS + idx];
    float r2 = re[i] * tc + im[i] * ts;
    float i2 = im[i] * tc - re[i] * ts;
    size_t o = (size_t)(rowbase + k1 * 64 + n2) * 512 + cb * 64 + c;
    fu[o] = f2bf(r2);
    fi[o] = f2bf(i2);
  }
}

__device__ __forceinline__ void fft2_task(const Params& p, int rowbase, int cb, float scale, char* smem) {
  float* sR = (float*)smem;
  float* sI = sR + 4096;
  const int tid = get_tid(), c = tid & 63;
  const int wq = __builtin_amdgcn_readfirstlane(tid >> 6);
  u16* fu = (u16*)(p.ws + OFF_FU);
  u16* fi = (u16*)(p.ws + OFF_FIM);
  const float* tab = (const float*)(p.ws + OFF_TAB);
  __syncthreads();
  for (int n2 = wq; n2 < 64; n2 += 4) {
    size_t o = (size_t)(rowbase + n2) * 512 + cb * 64 + c;
    sR[n2 * 64 + c] = bf2f(fu[o]);
    sI[n2 * 64 + c] = bf2f(fi[o]);
  }
  __syncthreads();
  const float* Fc = tab + TAB_F64C;
  const float* Fs = tab + TAB_F64S;
  float re[16], im[16];
#pragma unroll
  for (int i = 0; i < 16; i++) re[i] = 0.f, im[i] = 0.f;
  for (int n2 = 0; n2 < 64; n2++) {
    float xr = sR[n2 * 64 + c], xi = sI[n2 * 64 + c];
#pragma unroll
    for (int i = 0; i < 16; i++) {
      float fc = Fc[n2 * 64 + wq * 16 + i], fs = Fs[n2 * 64 + wq * 16 + i];
      re[i] += xr * fc + xi * fs;
      im[i] += xi * fc - xr * fs;
    }
  }
#pragma unroll
  for (int i = 0; i < 16; i++) {
    int k2 = wq * 16 + i;
    size_t o = (size_t)(rowbase + k2) * 512 + cb * 64 + c;
    fu[o] = f2bf(re[i] * scale);
    fi[o] = f2bf(im[i] * scale);
  }
}

template <bool P3>
__device__ __forceinline__ void s5_gemm_task(const Params& p, int task) {
  const int g = task / 17, cbk = task % 17;
  const int tid = get_tid(), lane = tid & 63, w = tid >> 6, fr = lane & 15, fq = lane >> 4;
  constexpr int LDA = P3 ? 512 : 256;
  constexpr int KT = P3 ? 16 : 8;
  const u16* Am = (const u16*)(p.ws + (P3 ? OFF_S5TH : OFF_S5M1)) + (size_t)g * 256 * LDA;
  u16* s5u = (u16*)(p.ws + OFF_S5U);
  u16* st = (u16*)(p.ws + OFF_S5ST);
  f32x4 acc[4][4];
#pragma unroll
  for (int i = 0; i < 4; i++)
#pragma unroll
    for (int j = 0; j < 4; j++) acc[i][j] = f32x4{0.f, 0.f, 0.f, 0.f};
  for (int ks = 0; ks < KT; ks++) {
    const int k0 = ks * 32 + fq * 8;
    bf16x8 af[4], bfr[4];
#pragma unroll
    for (int i = 0; i < 4; i++) af[i] = *(const bf16x8*)(Am + (size_t)(w * 64 + i * 16 + fr) * LDA + k0);
#pragma unroll
    for (int j = 0; j < 4; j++) {
      int cidx = cbk * 64 + j * 16 + fr;
      if (ks < 8) bfr[j] = *(const bf16x8*)(s5u + ((size_t)g * NTOK + cidx * 16) * 16 + k0);
      else bfr[j] = *(const bf16x8*)(st + ((size_t)cidx * 32 + g) * 256 + (k0 - 256));
    }
#pragma unroll
    for (int i = 0; i < 4; i++)
#pragma unroll
      for (int j = 0; j < 4; j++) acc[i][j] = __builtin_amdgcn_mfma_f32_16x16x32_bf16(af[i], bfr[j], acc[i][j], 0, 0, 0);
  }
  if (P3) __syncthreads();
#pragma unroll
  for (int i = 0; i < 4; i++) {
    int row = w * 64 + i * 16 + fq * 4;
#pragma unroll
    for (int j = 0; j < 4; j++) {
      int cidx = cbk * 64 + j * 16 + fr;
      uint2 o;
      if (P3) {
        o.x = pack2(gelu_tanh(acc[i][j][0]), gelu_tanh(acc[i][j][1]));
        o.y = pack2(gelu_tanh(acc[i][j][2]), gelu_tanh(acc[i][j][3]));
        *(uint2*)(s5u + ((size_t)g * NTOK + cidx * 16 + (row >> 4)) * 16 + (row & 15)) = o;
      } else {
        o.x = pack2(acc[i][j][0], acc[i][j][1]);
        o.y = pack2(acc[i][j][2], acc[i][j][3]);
        *(uint2*)(st + ((size_t)cidx * 32 + g) * 256 + row) = o;
      }
    }
  }
  if (P3) __syncthreads();
}

__device__ __forceinline__ void s5_scan_task(const Params& p, int l, int task) {
  const int idx = task * 256 + get_tid();
  const int pp = idx & 63, d = (idx >> 6) & 1, g = (idx >> 7) & 31, b = idx >> 12;
  const int pi = ((l * 2 + d) * 32 + g) * 64 + pp;
  const float step = expf(p.log_step[(l * 2 + d) * 32 + g]);
  const float lr = p.lam_re[pi], li = p.lam_im[pi];
  const float mag = expf(lr * step * 16.f);
  const float ar = mag * cosf(li * step * 16.f), ai = mag * sinf(li * step * 16.f);
  u16* st = (u16*)(p.ws + OFF_S5ST);
  float hr = 0.f, hi = 0.f;
  for (int s0 = 0; s0 < 272; s0 += 16) {
    float vr[16], vi[16];
    u16* ptr[16];
#pragma unroll
    for (int i = 0; i < 16; i++) {
      int s = s0 + i;
      int cidx;
      if (d == 0) cidx = (s < 16) ? (1024 + b * 16 + s) : (b * 256 + (s - 16));
      else cidx = (s < 16) ? (1024 + b * 16 + (15 - s)) : (b * 256 + 255 - (s - 16));
      ptr[i] = st + ((size_t)cidx * 32 + g) * 256 + d * 128 + pp;
      vr[i] = bf2f(ptr[i][0]);
      vi[i] = bf2f(ptr[i][64]);
    }
#pragma unroll
    for (int i = 0; i < 16; i++) {
      ptr[i][0] = f2bf(hr);
      ptr[i][64] = f2bf(hi);
      float nr = ar * hr - ai * hi + vr[i];
      float ni = ar * hi + ai * hr + vi[i];
      hr = nr;
      hi = ni;
    }
  }
}

__device__ __forceinline__ void ssd_acum(const Params& p, int l, int gc, int h, float* sA_, float* sDt, float* sAc) {
  const int tid = get_tid();
  const int d = tid >> 7, j = tid & 127;
  const float* dt = (const float*)(p.ws + OFF_DT);
  float dtv = dt[(size_t)(gc * 128 + j) * 32 + d * 16 + h];
  float aneg = -expf(p.a_log[l * 32 + d * 16 + h]);
  sA_[tid] = dtv * aneg;
  sDt[tid] = dtv;
  __syncthreads();
  float s = 0.f;
  if (d == 0) {
    for (int k = 0; k <= j; k++) s += sA_[k];
  } else {
    for (int k = 127; k >= j; k--) s += sA_[128 + k];
  }
  sAc[tid] = s;
  __syncthreads();
}

__device__ __forceinline__ void ssd_p1_task(const Params& p, int l, int task, char* smem) {
  const int gc = task >> 4, h = task & 15, g = h >> 3;
  u16* sBT = (u16*)smem;
  float* sA_ = (float*)(smem + 128 * 136 * 2);
  float* sDt = sA_ + 256;
  float* sAc = sDt + 256;
  float* sW = sAc + 256;
  const int tid = get_tid(), lane = tid & 63, w = tid >> 6, fr = lane & 15, fq = lane >> 4;
  __syncthreads();
  ssd_acum(p, l, gc, h, sA_, sDt, sAc);
  {
    int d = tid >> 7, j = tid & 127;
    float tot = (d == 0) ? sAc[127] : sAc[128];
    sW[tid] = sDt[tid] * __expf(tot - sAc[tid]);
    if (j == 0) ((float*)(p.ws + OFF_CDEC))[(gc * 16 + h) * 2 + d] = __expf(tot);
  }
  const u16* BN = (const u16*)(p.ws + OFF_BN);
#pragma unroll
  for (int i = 0; i < 8; i++) {
    int id = tid + 256 * i;
    int j = id >> 4, nc = id & 15;
    uint4 v = *(const uint4*)(BN + (size_t)(gc * 128 + j) * 256 + g * 128 + nc * 8);
    u16* d0 = sBT + (nc * 8) * 136 + j;
    d0[0] = (u16)(v.x & 0xffff); d0[136] = (u16)(v.x >> 16);
    d0[272] = (u16)(v.y & 0xffff); d0[408] = (u16)(v.y >> 16);
    d0[544] = (u16)(v.z & 0xffff); d0[680] = (u16)(v.z >> 16);
    d0[816] = (u16)(v.w & 0xffff); d0[952] = (u16)(v.w >> 16);
  }
  __syncthreads();
  const u16* XT = (const u16*)(p.ws + OFF_XT) + ((size_t)gc * 1024 + h * 64 + w * 16 + fr) * 128;
  f32x4 accf[8], accb[8];
#pragma unroll
  for (int i = 0; i < 8; i++) accf[i] = f32x4{0.f, 0.f, 0.f, 0.f}, accb[i] = f32x4{0.f, 0.f, 0.f, 0.f};
#pragma unroll
  for (int ks = 0; ks < 4; ks++) {
    const int k0 = ks * 32 + fq * 8;
    uint4 xv = *(const uint4*)(XT + k0);
    float xf[8] = {lo16(xv.x), hi16(xv.x), lo16(xv.y), hi16(xv.y), lo16(xv.z), hi16(xv.z), lo16(xv.w), hi16(xv.w)};
    uint4 af, ab;
    af.x = pack2(xf[0] * sW[k0 + 0], xf[1] * sW[k0 + 1]);
    af.y = pack2(xf[2] * sW[k0 + 2], xf[3] * sW[k0 + 3]);
    af.z = pack2(xf[4] * sW[k0 + 4], xf[5] * sW[k0 + 5]);
    af.w = pack2(xf[6] * sW[k0 + 6], xf[7] * sW[k0 + 7]);
    ab.x = pack2(xf[0] * sW[128 + k0 + 0], xf[1] * sW[128 + k0 + 1]);
    ab.y = pack2(xf[2] * sW[128 + k0 + 2], xf[3] * sW[128 + k0 + 3]);
    ab.z = pack2(xf[4] * sW[128 + k0 + 4], xf[5] * sW[128 + k0 + 5]);
    ab.w = pack2(xf[6] * sW[128 + k0 + 6], xf[7] * sW[128 + k0 + 7]);
    bf16x8 fa = as_frag(af), fb = as_frag(ab);
#pragma unroll
    for (int nf = 0; nf < 8; nf++) {
      bf16x8 bfr = *(const bf16x8*)(sBT + (nf * 16 + fr) * 136 + k0);
      accf[nf] = __builtin_amdgcn_mfma_f32_16x16x32_bf16(fa, bfr, accf[nf], 0, 0, 0);
      accb[nf] = __builtin_amdgcn_mfma_f32_16x16x32_bf16(fb, bfr, accb[nf], 0, 0, 0);
    }
  }
  u16* st = (u16*)(p.ws + OFF_ST) + (size_t)(gc * 16 + h) * 2 * 8192;
#pragma unroll
  for (int nf = 0; nf < 8; nf++) {
#pragma unroll
    for (int j = 0; j < 4; j++) {
      int pr = w * 16 + fq * 4 + j, n = nf * 16 + fr;
      st[(size_t)pr * 128 + n] = f2bf(accf[nf][j]);
      st[8192 + (size_t)pr * 128 + n] = f2bf(accb[nf][j]);
    }
  }
}

__device__ __forceinline__ void ssd_p2_task(const Params& p, int task) {
  const int e = task * 256 + get_tid();
  const int pn = e & 8191, d = (e >> 13) & 1, h = (e >> 14) & 15, b = e >> 18;
  u16* st = (u16*)(p.ws + OFF_ST) + (size_t)(h * 2 + d) * 8192 + pn;
  const float* cdec = (const float*)(p.ws + OFF_CDEC) + h * 2 + d;
  float hs = 0.f;
#pragma unroll 1
  for (int s0 = 0; s0 < 34; s0 += 17) {
    float v[17], dc[17];
#pragma unroll
    for (int i = 0; i < 17; i++) {
      int s = s0 + i, gc;
      if (d == 0) gc = (s < 2) ? (128 + 2 * b + s) : (32 * b + (s - 2));
      else gc = (s < 2) ? (128 + 2 * b + (1 - s)) : (32 * b + 31 - (s - 2));
      v[i] = bf2f(st[(unsigned)gc * (16u * 2u * 8192u)]);
      dc[i] = cdec[gc * 32];
    }
#pragma unroll
    for (int i = 0; i < 17; i++) {
      int s = s0 + i, gc;
      if (d == 0) gc = (s < 2) ? (128 + 2 * b + s) : (32 * b + (s - 2));
      else gc = (s < 2) ? (128 + 2 * b + (1 - s)) : (32 * b + 31 - (s - 2));
      st[(unsigned)gc * (16u * 2u * 8192u)] = f2bf(hs);
      hs = hs * dc[i] + v[i];
    }
  }
}

__device__ __forceinline__ void ssd_p3_task(const Params& p, int l, int task, char* smem) {
  const int gc = task >> 4, h = task & 15, g = h >> 3;
  u16* sM = (u16*)smem;
  float* sA_ = (float*)(smem + 128 * 136 * 2);
  float* sDt = sA_ + 256;
  float* sAc = sDt + 256;
  const int tid = get_tid(), lane = tid & 63, w = tid >> 6, fr = lane & 15, fq = lane >> 4;
  __syncthreads();
  ssd_acum(p, l, gc, h, sA_, sDt, sAc);
  const u16* BN = (const u16*)(p.ws + OFF_BN) + (size_t)(gc * 128) * 256 + g * 128;
  const u16* CN = (const u16*)(p.ws + OFF_CN) + (size_t)(gc * 128) * 256 + g * 128;
  const u16* XT = (const u16*)(p.ws + OFF_XT) + ((size_t)gc * 1024 + h * 64) * 128;
  f32x4 G[2][8];
#pragma unroll
  for (int a = 0; a < 2; a++)
#pragma unroll
    for (int c = 0; c < 8; c++) G[a][c] = f32x4{0.f, 0.f, 0.f, 0.f};
#pragma unroll
  for (int ks = 0; ks < 4; ks++) {
    const int k0 = ks * 32 + fq * 8;
    bf16x8 af[2];
#pragma unroll
    for (int a = 0; a < 2; a++) af[a] = *(const bf16x8*)(BN + (size_t)(w * 32 + a * 16 + fr) * 256 + k0);
#pragma unroll
    for (int c = 0; c < 8; c++) {
      bf16x8 bfr = *(const bf16x8*)(CN + (size_t)(c * 16 + fr) * 256 + k0);
#pragma unroll
      for (int a = 0; a < 2; a++) G[a][c] = __builtin_amdgcn_mfma_f32_16x16x32_bf16(af[a], bfr, G[a][c], 0, 0, 0);
    }
  }
  f32x4 acc[2][4];
#pragma unroll
  for (int a = 0; a < 2; a++)
#pragma unroll
    for (int c = 0; c < 4; c++) acc[a][c] = f32x4{0.f, 0.f, 0.f, 0.f};

#pragma unroll
  for (int d = 0; d < 2; d++) {
    const float* ac = sAc + d * 128;
    const float* dtp = sDt + d * 128;
#pragma unroll
    for (int a = 0; a < 2; a++) {
      const int j0 = w * 32 + a * 16 + fq * 4;
      const float aj0 = ac[j0], aj1 = ac[j0 + 1], aj2 = ac[j0 + 2], aj3 = ac[j0 + 3];
#pragma unroll
      for (int c = 0; c < 8; c++) {
        const int i = c * 16 + fr;
        const float ai = ac[i];
        float m0, m1, m2, m3;
        if (d == 0) {
          m0 = (j0 + 0 <= i) ? G[a][c][0] * __expf(ai - aj0) : 0.f;
          m1 = (j0 + 1 <= i) ? G[a][c][1] * __expf(ai - aj1) : 0.f;
          m2 = (j0 + 2 <= i) ? G[a][c][2] * __expf(ai - aj2) : 0.f;
          m3 = (j0 + 3 <= i) ? G[a][c][3] * __expf(ai - aj3) : 0.f;
        } else {
          m0 = (j0 + 0 >= i) ? G[a][c][0] * __expf(ai - aj0) : 0.f;
          m1 = (j0 + 1 >= i) ? G[a][c][1] * __expf(ai - aj1) : 0.f;
          m2 = (j0 + 2 >= i) ? G[a][c][2] * __expf(ai - aj2) : 0.f;
          m3 = (j0 + 3 >= i) ? G[a][c][3] * __expf(ai - aj3) : 0.f;
        }
        uint2 o;
        o.x = pack2(m0, m1);
        o.y = pack2(m2, m3);
        *(uint2*)(sM + i * 136 + j0) = o;
      }
    }
    __syncthreads();
#pragma unroll
    for (int ks = 0; ks < 4; ks++) {
      const int k0 = ks * 32 + fq * 8;
      bf16x8 af[2];
#pragma unroll
      for (int a = 0; a < 2; a++) af[a] = *(const bf16x8*)(sM + (w * 32 + a * 16 + fr) * 136 + k0);
#pragma unroll
      for (int c = 0; c < 4; c++) {
        uint4 xv = *(const uint4*)(XT + (size_t)(c * 16 + fr) * 128 + k0);
        uint4 xb;
        xb.x = pack2(lo16(xv.x) * dtp[k0 + 0], hi16(xv.x) * dtp[k0 + 1]);
        xb.y = pack2(lo16(xv.y) * dtp[k0 + 2], hi16(xv.y) * dtp[k0 + 3]);
        xb.z = pack2(lo16(xv.z) * dtp[k0 + 4], hi16(xv.z) * dtp[k0 + 5]);
        xb.w = pack2(lo16(xv.w) * dtp[k0 + 6], hi16(xv.w) * dtp[k0 + 7]);
        bf16x8 bfr = as_frag(xb);
#pragma unroll
        for (int a = 0; a < 2; a++) acc[a][c] = __builtin_amdgcn_mfma_f32_16x16x32_bf16(af[a], bfr, acc[a][c], 0, 0, 0);
      }
    }
    f32x4 tmp[2][4];
#pragma unroll
    for (int a = 0; a < 2; a++)
#pragma unroll
      for (int c = 0; c < 4; c++) tmp[a][c] = f32x4{0.f, 0.f, 0.f, 0.f};
    const u16* hin = (const u16*)(p.ws + OFF_ST) + ((size_t)(gc * 16 + h) * 2 + d) * 8192;
#pragma unroll
    for (int ks = 0; ks < 4; ks++) {
      const int k0 = ks * 32 + fq * 8;
      bf16x8 af[2];
#pragma unroll
      for (int a = 0; a < 2; a++) af[a] = *(const bf16x8*)(CN + (size_t)(w * 32 + a * 16 + fr) * 256 + k0);
#pragma unroll
      for (int c = 0; c < 4; c++) {
        bf16x8 bfr = *(const bf16x8*)(hin + (size_t)(c * 16 + fr) * 128 + k0);
#pragma unroll
        for (int a = 0; a < 2; a++) tmp[a][c] = __builtin_amdgcn_mfma_f32_16x16x32_bf16(af[a], bfr, tmp[a][c], 0, 0, 0);
      }
    }
#pragma unroll
    for (int a = 0; a < 2; a++) {
      const int i0 = w * 32 + a * 16 + fq * 4;
      float e0 = __expf(ac[i0]), e1 = __expf(ac[i0 + 1]), e2 = __expf(ac[i0 + 2]), e3 = __expf(ac[i0 + 3]);
#pragma unroll
      for (int c = 0; c < 4; c++) {
        acc[a][c][0] += tmp[a][c][0] * e0;
        acc[a][c][1] += tmp[a][c][1] * e1;
        acc[a][c][2] += tmp[a][c][2] * e2;
        acc[a][c][3] += tmp[a][c][3] * e3;
      }
    }
    __syncthreads();
  }
  const float dsk = p.d_ssd[l * 16 + h];
  u16* z = (u16*)(p.ws + OFF_Z);
  float* ssq = (float*)(p.ws + OFF_SSQV);
#pragma unroll
  for (int a = 0; a < 2; a++) {
    const int i0 = w * 32 + a * 16 + fq * 4;
    float sq[4] = {0.f, 0.f, 0.f, 0.f};
#pragma unroll
    for (int c = 0; c < 4; c++) {
      const int pc = c * 16 + fr;
      uint2 xv = *(const uint2*)(XT + (size_t)pc * 128 + i0);
      float xs[4] = {lo16(xv.x), hi16(xv.x), lo16(xv.y), hi16(xv.y)};
#pragma unroll
      for (int j = 0; j < 4; j++) {
        size_t zi = (size_t)(gc * 128 + i0 + j) * 1024 + h * 64 + pc;
        float zv = bf2f(z[zi]);
        float y = acc[a][c][j] + dsk * xs[j];
        float v = y * silu_f(zv);
        z[zi] = f2bf(v);
        sq[j] += v * v;
      }
    }
#pragma unroll
    for (int j = 0; j < 4; j++) {
      float s = sum16(sq[j]);
      if (fr == 0) ssq[(size_t)(gc * 128 + i0 + j) * 16 + h] = s;
    }
  }
}

__device__ __forceinline__ void resid_task(const Params& p, int l, int task) {
  const int lane = get_tid() & 63, w = get_tid() >> 6;
  const int r = task * 4 + w;
  if (l == NLAYER - 1 && r >= NLAT) return;
  const int b5 = (r < NLAT) ? (r >> 12) : 4;
  const int k0 = lane * 16;
  const float* sq = (const float*)(p.ws + OFF_SSQY) + (size_t)r * 16;
  float s = 0.f;
#pragma unroll
  for (int i = 0; i < 4; i++) {
    float4 q = *(const float4*)(sq + i * 4);
    s += q.x + q.y + q.z + q.w;
  }
  const float rsy = rsqrtf(s * (1.f / 1024.f) + EPSV);
  const u16* y = (const u16*)(p.ws + OFF_FU) + (size_t)r * 1024 + k0;
  uint4 y0 = *(const uint4*)y, y1 = *(const uint4*)(y + 8);
  float yv[16] = {lo16(y0.x), hi16(y0.x), lo16(y0.y), hi16(y0.y), lo16(y0.z), hi16(y0.z), lo16(y0.w), hi16(y0.w),
                  lo16(y1.x), hi16(y1.x), lo16(y1.y), hi16(y1.y), lo16(y1.z), hi16(y1.z), lo16(y1.w), hi16(y1.w)};
  const float* gate = (const float*)(p.ws + OFF_MOD) + (size_t)(l * 5 + b5) * 3072 + 2048 + k0;
  const float* gp = p.g_post + l * 1024 + k0;
  const float* src = res_src(p, l, r) + k0;
  float* dst = ((r < NLAT) ? p.out + (size_t)r * DM : (float*)(p.ws + OFF_XC) + (size_t)(r - NLAT) * DM) + k0;
  float ss = 0.f;
#pragma unroll
  for (int i = 0; i < 4; i++) {
    float4 xo = *(const float4*)(src + i * 4);
    float4 gt = *(const float4*)(gate + i * 4);
    float4 gq = *(const float4*)(gp + i * 4);
    float4 o;
    o.x = xo.x + gt.x * (yv[i * 4 + 0] * rsy * gq.x);
    o.y = xo.y + gt.y * (yv[i * 4 + 1] * rsy * gq.y);
    o.z = xo.z + gt.z * (yv[i * 4 + 2] * rsy * gq.z);
    o.w = xo.w + gt.w * (yv[i * 4 + 3] * rsy * gq.w);
    *(float4*)(dst + i * 4) = o;
    ss += o.x * o.x + o.y * o.y + o.z * o.z + o.w * o.w;
  }
  ss = wave_sum(ss);
  if (lane == 0) ((float*)(p.ws + OFF_RS))[r] = rsqrtf(ss * (1.f / 1024.f) + EPSV);
}

__device__ __forceinline__ void run_phase(const Params& p, int ph, char* smem) {
  const int nb = gridDim.x, b0 = blockIdx.x;
  if (ph == 0) {
    const int total = 48 + 1 + 4352 + PREP_TASKS;
    for (int t = b0; t < total; t += nb) {
      if (t < 48) mod_task(p, t, smem);
      else if (t < 49) tables_task(p);
      else if (t < 49 + PREP_TASKS) prep_task(p, 0, t - 49, smem);
      else rowstat_task(p, t - 49 - PREP_TASKS);
    }
    return;
  }
  const int l = (ph - 1) / 7, s = (ph - 1) % 7;
  const bool last = (l == NLAYER - 1);
  if (s == 0) {
    for (int t = b0; t < 136 * 37; t += nb) gemm_tile<0>(p, l, t / 37, t % 37, smem);
  } else if (s == 1) {
    const int total = 544 + 3264 + 2048 + 2048;
    for (int t = b0; t < total; t += nb) {
      if (t < 544) s5_gemm_task<false>(p, t);
      else if (t < 544 + 3264) conv_task(p, l, t - 544, smem);
      else if (t < 544 + 3264 + 2048) {
        int q = t - 544 - 3264;
        int b = q >> 9, n2 = (q >> 3) & 63, cb = q & 7;
        fft1_task<64>(p, b * 4096, n2, cb, smem);
      } else {
        int q = t - 544 - 3264 - 2048;
        int b = q >> 9, n2 = (q >> 3) & 63, cb = q & 7;
        if (!last) fft1_task<4>(p, NLAT + b * 256, n2, cb, smem);
      }
    }
  } else if (s == 2) {
    const int total = 64 + 2176 + 2048 + 128;
    for (int t = b0; t < total; t += nb) {
      if (t < 64) s5_scan_task(p, l, t);
      else if (t < 64 + 2176) ssd_p1_task(p, l, t - 64, smem);
      else if (t < 64 + 2176 + 2048) {
        int q = t - 64 - 2176;
        int b = q >> 9, k1 = (q >> 3) & 63, cb = q & 7;
        fft2_task(p, b * 4096 + k1 * 64, cb, 1.f / 64.f, smem);
      } else {
        int q = t - 64 - 2176 - 2048;
        int b = q >> 5, k1 = (q >> 3) & 3, cb = q & 7;
        if (!last) fft2_task(p, NLAT + b * 256 + k1 * 64, cb, 1.f / 16.f, smem);
      }
    }
  } else if (s == 3) {
    const int total = 4096 + 544 + 544;
    for (int t = b0; t < total; t += nb) {
      if (t < 4096) ssd_p2_task(p, t);
      else if (t < 4096 + 544) s5_gemm_task<true>(p, t - 4096);
      else {
        int q = t - 4096 - 544;
        int mt = q >> 2, nt = q & 3;
        if (!(last && mt >= 128)) gemm_tile<2>(p, l, mt, nt, smem);
      }
    }
  } else if (s == 4) {
    const int total = 2176 + 544;
    for (int t = b0; t < total; t += nb) {
      if (t < 2176) ssd_p3_task(p, l, t, smem);
      else {
        int q = t - 2176;
        int mt = q >> 2, nt = q & 3;
        if (!(last && mt >= 128)) gemm_tile<3>(p, l, mt, nt, smem);
      }
    }
  } else if (s == 5) {
    const int nmt = last ? 128 : 136;
    for (int t = b0; t < nmt * 8; t += nb) gemm_tile<1>(p, l, t >> 3, t & 7, smem);
  } else {
    const int total = 4352 + (last ? 0 : PREP_TASKS);
    for (int t = b0; t < total; t += nb) {
      if (!last && t < PREP_TASKS) prep_task(p, l + 1, t, smem);
      else resid_task(p, l, t - (last ? 0 : PREP_TASKS));
    }
  }
}

__global__ void __launch_bounds__(256) mega_kernel(Params p, int ph0, int ph1, int coop) {
  __shared__ __attribute__((aligned(16))) char smem[SMEM_BYTES];
  cg::grid_group grid = cg::this_grid();
  for (int ph = ph0; ph < ph1; ph++) {
    run_phase(p, ph, smem);
    if (coop && ph + 1 < ph1) grid.sync();
  }
}

__global__ void fill_kernel(float* o, int n, float v) {
  int i = blockIdx.x * 256 + threadIdx.x;
  if (i < n) o[i] = v;
}

extern "C" void kernel_launch(void* const* d_in, const int* in_sizes, int n_in, void* d_out, int out_size, void* d_ws,
                              size_t ws_size, hipStream_t stream) {
  static int grid_blocks = 0;
  if (!grid_blocks) {
    int dev = 0, cus = 0, per_cu = 0;
    hipGetDevice(&dev);
    hipDeviceGetAttribute(&cus, hipDeviceAttributeMultiprocessorCount, dev);
    hipOccupancyMaxActiveBlocksPerMultiprocessor(&per_cu, mega_kernel, 256, 0);
    if (per_cu < 1) per_cu = 1;
    if (per_cu > 2) per_cu = 2;
    grid_blocks = cus * per_cu;
  }
  if (ws_size < WS_NEED || n_in != 28) {
    fill_kernel<<<(out_size + 255) / 256, 256, 0, stream>>>((float*)d_out, out_size, 7777.f);
    return;
  }
  Params p{};
  const float** pp = (const float**)&p;
  for (int i = 0; i < 28; i++) pp[i] = (const float*)d_in[i];
  p.out = (float*)d_out;
  p.ws = (char*)d_ws;
  const int NPH = 1 + 7 * NLAYER;
#if MULTI_LAUNCH
  for (int ph = 0; ph < NPH; ph++) {
    hipLaunchKernelGGL(mega_kernel, dim3(grid_blocks), dim3(256), 0, stream, p, ph, ph + 1, 0);
  }
#else
  int ph0 = 0, ph1 = NPH, coop = 1;
  void* args[] = {&p, &ph0, &ph1, &coop};
  hipError_t e = hipLaunchCooperativeKernel((void*)mega_kernel, dim3(grid_blocks), dim3(256), args, 0, stream);
  if (e != hipSuccess) fprintf(stderr, "cooperative launch failed: %s (grid %d)\n", hipGetErrorString(e), grid_blocks);
#endif
}
```

```cpp
#include <hip/hip_runtime.h>
#include <hip/hip_bf16.h>
#include <hip/hip_cooperative_groups.h>
#include <cstdio>
namespace cg = cooperative_groups;

#ifndef MULTI_LAUNCH
#define MULTI_LAUNCH 0
#endif

typedef unsigned short u16;
using bf16x8 = __attribute__((ext_vector_type(8))) short;
using f32x4 = __attribute__((ext_vector_type(4))) float;

#define NLAT 16384
#define NCTX 1024
#define NTOK 17408
#define DM 1024
#define DINP 4736
#define DIN 4640
#define NLAYER 4
#define EPSV 1e-6f

constexpr size_t al256(size_t x) { return (x + 255) & ~size_t(255); }
constexpr size_t OFF_XC = 0;
constexpr size_t OFF_RS = OFF_XC + al256((size_t)1024 * 1024 * 4);
constexpr size_t OFF_MOD = OFF_RS + al256((size_t)NTOK * 4);
constexpr size_t OFF_DT = OFF_MOD + al256((size_t)4 * 5 * 3072 * 4);
constexpr size_t OFF_SSQV = OFF_DT + al256((size_t)NTOK * 32 * 4);
constexpr size_t OFF_SSQY = OFF_SSQV + al256((size_t)NTOK * 16 * 4);
constexpr size_t OFF_CDEC = OFF_SSQY + al256((size_t)NTOK * 16 * 4);
constexpr size_t OFF_TAB = OFF_CDEC + al256((size_t)136 * 16 * 2 * 4);
constexpr int TAB_F64C = 0, TAB_F64S = 4096, TAB_F4C = 8192, TAB_F4S = 8208, TAB_TWC = 8224, TAB_TWS = 12320, TAB_N = 16416;
constexpr size_t OFF_KTAB = OFF_TAB + al256((size_t)TAB_N * 4);
constexpr size_t OFF_Z = OFF_KTAB + al256((size_t)32 * 8192 * 4);
constexpr size_t OFF_S5U = OFF_Z + al256((size_t)NTOK * 1024 * 2);
constexpr size_t OFF_S5G = OFF_S5U + al256((size_t)NTOK * 512 * 2);
constexpr size_t OFF_FU = OFF_S5G + al256((size_t)NTOK * 512 * 2);
constexpr size_t OFF_FIM = OFF_FU + (size_t)NTOK * 512 * 2;
constexpr size_t OFF_FG = OFF_FIM + al256((size_t)NTOK * 512 * 2);
constexpr size_t OFF_S5ST = OFF_FG + al256((size_t)NTOK * 512 * 2);
constexpr size_t OFF_WOUTT = OFF_S5ST + al256((size_t)1088 * 32 * 256 * 2);
constexpr size_t OFF_GLUT = OFF_WOUTT + al256((size_t)1024 * 2048 * 2);
constexpr size_t OFF_WCST = OFF_GLUT + al256((size_t)512 * 512 * 2);
constexpr size_t OFF_S5M1 = OFF_WCST + al256((size_t)512 * 1024 * 2);
constexpr size_t OFF_S5TH = OFF_S5M1 + al256((size_t)32 * 256 * 256 * 2);
constexpr size_t OFF_R3 = OFF_S5TH + al256((size_t)32 * 256 * 512 * 2);
constexpr size_t OFF_XT = OFF_R3;
constexpr size_t OFF_BN = OFF_XT + (size_t)136 * 1024 * 128 * 2;
constexpr size_t OFF_CN = OFF_BN + (size_t)NTOK * 256 * 2;
constexpr size_t OFF_WINT = OFF_R3;
constexpr size_t OFF_H = OFF_R3 + (size_t)DINP * 1024 * 2;
constexpr size_t OFF_R4 = OFF_CN + (size_t)NTOK * 256 * 2;
constexpr size_t OFF_ST = OFF_R4;
constexpr size_t OFF_RAW = OFF_R4;
constexpr size_t WS_NEED = OFF_R4 + (size_t)136 * 16 * 2 * 8192 * 2;

#define SMEM_BYTES 73728

struct Params {
  const float *x, *c, *ctx, *c_ctx, *w_mod, *b_mod, *g_pre, *g_post, *w_in, *conv_w, *conv_b, *dt_bias, *a_log,
      *d_ssd, *g_ssd_norm, *lam_re, *lam_im, *log_step, *b_re, *b_im, *c_re, *c_im, *s5_d, *w_glu, *b_glu, *fnet_w,
      *fnet_b, *w_out;
  float* out;
  char* ws;
};

__device__ __forceinline__ u16 f2bf(float f) {
  unsigned u = __float_as_uint(f);
  u += 0x7fffu + ((u >> 16) & 1u);
  return (u16)(u >> 16);
}
__device__ __forceinline__ float bf2f(u16 h) { return __uint_as_float(((unsigned)h) << 16); }
__device__ __forceinline__ unsigned pack2(float a, float b) { return (unsigned)f2bf(a) | ((unsigned)f2bf(b) << 16); }
__device__ __forceinline__ float lo16(unsigned u) { return __uint_as_float(u << 16); }
__device__ __forceinline__ float hi16(unsigned u) { return __uint_as_float(u & 0xffff0000u); }
__device__ __forceinline__ float silu_f(float x) { return x / (1.f + __expf(-x)); }
__device__ __forceinline__ float sigmoid_f(float x) { return 1.f / (1.f + __expf(-x)); }
__device__ __forceinline__ float gelu_tanh(float x) {
  float u = 0.7978845608028654f * (x + 0.044715f * x * x * x);
  return x / (1.f + __expf(-2.f * u));
}
__device__ __forceinline__ float softplus_f(float x) { return x > 20.f ? x : log1pf(expf(x)); }
__device__ __forceinline__ int get_tid() {
  int t = threadIdx.x;
  asm volatile("" : "+v"(t));
  return t;
}
__device__ __forceinline__ bf16x8 as_frag(uint4 v) {
  union { uint4 u; bf16x8 f; } cv;
  cv.u = v;
  return cv.f;
}
__device__ __forceinline__ float wave_sum(float v) {
#pragma unroll
  for (int o = 32; o > 0; o >>= 1) v += __shfl_xor(v, o, 64);
  return v;
}
__device__ __forceinline__ float sum16(float v) {
#pragma unroll
  for (int o = 8; o > 0; o >>= 1) v += __shfl_xor(v, o, 64);
  return v;
}

__device__ __forceinline__ const float* res_src(const Params& p, int l, int r) {
  if (l == 0) return (r < NLAT) ? p.x + (size_t)r * DM : p.ctx + (size_t)(r - NLAT) * DM;
  return (r < NLAT) ? p.out + (size_t)r * DM : (const float*)(p.ws + OFF_XC) + (size_t)(r - NLAT) * DM;
}

template <int MODE>
__device__ __forceinline__ uint4 gemm_loadA(const Params& p, int l, int r, int k) {
  char* ws = p.ws;
  if (MODE == 0) {
    return *(const uint4*)((const u16*)(ws + OFF_H) + (size_t)r * 1024 + k);
  } else if (MODE == 1) {
    if (k < 1024) {
      uint4 v = *(const uint4*)((const u16*)(ws + OFF_Z) + (size_t)r * 1024 + k);
      const float* sq = (const float*)(ws + OFF_SSQV) + (size_t)r * 16 + (k >> 9) * 8;
      float4 q0 = *(const float4*)sq, q1 = *(const float4*)(sq + 4);
      float sc = rsqrtf((q0.x + q0.y + q0.z + q0.w + q1.x + q1.y + q1.z + q1.w) * (1.f / 512.f) + EPSV);
      const float* gn = p.g_ssd_norm + l * 1024 + k;
      float4 g0 = *(const float4*)gn, g1 = *(const float4*)(gn + 4);
      uint4 o;
      o.x = pack2(lo16(v.x) * sc * g0.x, hi16(v.x) * sc * g0.y);
      o.y = pack2(lo16(v.y) * sc * g0.z, hi16(v.y) * sc * g0.w);
      o.z = pack2(lo16(v.z) * sc * g1.x, hi16(v.z) * sc * g1.y);
      o.w = pack2(lo16(v.w) * sc * g1.z, hi16(v.w) * sc * g1.w);
      return o;
    } else if (k < 1536) {
      return *(const uint4*)((const u16*)(ws + OFF_S5G) + (size_t)r * 512 + (k - 1024));
    } else {
      return *(const uint4*)((const u16*)(ws + OFF_FG) + (size_t)r * 512 + (k - 1536));
    }
  } else if (MODE == 2) {
    if (k < 512) return *(const uint4*)((const u16*)(ws + OFF_FU) + (size_t)r * 512 + k);
    return *(const uint4*)((const u16*)(ws + OFF_FIM) + (size_t)r * 512 + (k - 512));
  } else {
    return *(const uint4*)((const u16*)(ws + OFF_S5U) + ((size_t)(k >> 4) * NTOK + r) * 16 + (k & 15));
  }
}

template <int MODE>
__device__ __forceinline__ void gemm_epi(const Params& p, int l, int row0, int col0, int fr, const f32x4& a, int slot) {
  char* ws = p.ws;
  int col = col0 + fr;
  if (MODE == 0) {
    if (col0 < 1024) {
      u16* z = (u16*)(ws + OFF_Z);
#pragma unroll
      for (int j = 0; j < 4; j++) z[(size_t)(row0 + j) * 1024 + col] = f2bf(a[j]);
    } else if (col0 < 2560) {
      u16* raw = (u16*)(ws + OFF_RAW);
#pragma unroll
      for (int j = 0; j < 4; j++) raw[(size_t)(row0 + j) * 1536 + (col - 1024)] = f2bf(a[j]);
    } else if (col0 < 3072) {
      u16* u = (u16*)(ws + OFF_S5U);
      int g = (col0 - 2560) >> 4;
#pragma unroll
      for (int j = 0; j < 4; j++) u[((size_t)g * NTOK + row0 + j) * 16 + fr] = f2bf(a[j]);
    } else if (col0 < 3584) {
      u16* d = (u16*)(ws + OFF_S5G);
#pragma unroll
      for (int j = 0; j < 4; j++) d[(size_t)(row0 + j) * 512 + (col - 3072)] = f2bf(a[j]);
    } else if (col0 < 4096) {
      u16* d = (u16*)(ws + OFF_FU);
#pragma unroll
      for (int j = 0; j < 4; j++) d[(size_t)(row0 + j) * 512 + (col - 3584)] = f2bf(a[j]);
    } else if (col0 < 4608) {
      u16* d = (u16*)(ws + OFF_FG);
#pragma unroll
      for (int j = 0; j < 4; j++) d[(size_t)(row0 + j) * 512 + (col - 4096)] = f2bf(a[j]);
    } else if (col0 < 4640) {
      float* d = (float*)(ws + OFF_DT);
      float bias = p.dt_bias[l * 32 + (col - 4608)];
#pragma unroll
      for (int j = 0; j < 4; j++) d[(size_t)(row0 + j) * 32 + (col - 4608)] = softplus_f(a[j] + bias);
    }
  } else if (MODE == 1) {
    u16* y = (u16*)(ws + OFF_FU);
#pragma unroll
    for (int j = 0; j < 4; j++) y[(size_t)(row0 + j) * 1024 + col] = f2bf(a[j]);
  } else if (MODE == 2) {
    u16* fg = (u16*)(ws + OFF_FG);
    float bias = p.fnet_b[l * 512 + col];
#pragma unroll
    for (int j = 0; j < 4; j++) {
      int r = row0 + j, rr;
      if (r < NLAT) {
        int pos = r & 4095;
        rr = (r & ~4095) + (pos >> 6) + 64 * (pos & 63);
      } else {
        int q = r - NLAT;
        int pos = q & 255;
        rr = NLAT + (q & ~255) + (pos >> 6) + 4 * (pos & 63);
      }
      size_t idx = (size_t)rr * 512 + col;
      float g = bf2f(fg[idx]);
      fg[idx] = f2bf((a[j] + bias) * silu_f(g));
    }
  } else {
    u16* sg = (u16*)(ws + OFF_S5G);
    const u16* sv = (const u16*)(ws + OFF_S5U);
    float bias = p.b_glu[l * 512 + col];
#pragma unroll
    for (int j = 0; j < 4; j++) {
      int r = row0 + j;
      float v = bf2f(sv[((size_t)(col >> 4) * NTOK + r) * 16 + (col & 15)]);
      size_t idx = (size_t)r * 512 + col;
      float g = bf2f(sg[idx]);
      sg[idx] = f2bf(v * sigmoid_f(a[j] + bias) * silu_f(g));
    }
  }
}

template <int MODE>
__device__ __forceinline__ void gemm_tile(const Params& p, int l, int mt, int nt, char* smem) {
  constexpr int K = (MODE == 0) ? 1024 : (MODE == 1) ? 2048 : (MODE == 2) ? 1024 : 512;
  constexpr int NKT = K / 32;
  const u16* Bt = (const u16*)(p.ws + ((MODE == 0) ? OFF_WINT : (MODE == 1) ? OFF_WOUTT : (MODE == 2) ? OFF_WCST : OFF_GLUT));
  u16* sA = (u16*)smem;
  u16* sB = sA + 2 * 128 * 32;
  const int tid = get_tid(), lane = tid & 63, w = tid >> 6, wm = w >> 1, wn = w & 1;
  const int fr = lane & 15, fq = lane >> 4;
  const int lr0 = tid >> 2, kc = tid & 3;
  const int rowA0 = mt * 128 + lr0, rowA1 = rowA0 + 64;
  const u16* bp0 = Bt + (size_t)(nt * 128 + lr0) * K + kc * 8;
  const u16* bp1 = bp0 + (size_t)64 * K;

  f32x4 acc[4][4];
#pragma unroll
  for (int i = 0; i < 4; i++)
#pragma unroll
    for (int j = 0; j < 4; j++) acc[i][j] = f32x4{0.f, 0.f, 0.f, 0.f};

  uint4 ra0 = gemm_loadA<MODE>(p, l, rowA0, kc * 8);
  uint4 ra1 = gemm_loadA<MODE>(p, l, rowA1, kc * 8);
  uint4 rb0 = *(const uint4*)bp0;
  uint4 rb1 = *(const uint4*)bp1;
  __syncthreads();
  *(uint4*)(sA + tid * 8) = ra0;
  *(uint4*)(sA + (tid + 256) * 8) = ra1;
  *(uint4*)(sB + tid * 8) = rb0;
  *(uint4*)(sB + (tid + 256) * 8) = rb1;
  __syncthreads();

  for (int kt = 0; kt < NKT; kt++) {
    const int cur = kt & 1;
    if (kt + 1 < NKT) {
      int k = (kt + 1) * 32 + kc * 8;
      ra0 = gemm_loadA<MODE>(p, l, rowA0, k);
      ra1 = gemm_loadA<MODE>(p, l, rowA1, k);
      rb0 = *(const uint4*)(bp0 + (kt + 1) * 32);
      rb1 = *(const uint4*)(bp1 + (kt + 1) * 32);
    }
    const u16* cA = sA + cur * 4096;
    const u16* cB = sB + cur * 4096;
    bf16x8 af[4], bfr[4];
#pragma unroll
    for (int i = 0; i < 4; i++) af[i] = *(const bf16x8*)(cA + (wm * 64 + i * 16 + fr) * 32 + fq * 8);
#pragma unroll
    for (int i = 0; i < 4; i++) bfr[i] = *(const bf16x8*)(cB + (wn * 64 + i * 16 + fr) * 32 + fq * 8);
#pragma unroll
    for (int i = 0; i < 4; i++)
#pragma unroll
      for (int j = 0; j < 4; j++) acc[i][j] = __builtin_amdgcn_mfma_f32_16x16x32_bf16(af[i], bfr[j], acc[i][j], 0, 0, 0);
    if (kt + 1 < NKT) {
      u16* nA = sA + (cur ^ 1) * 4096;
      u16* nB = sB + (cur ^ 1) * 4096;
      *(uint4*)(nA + tid * 8) = ra0;
      *(uint4*)(nA + (tid + 256) * 8) = ra1;
      *(uint4*)(nB + tid * 8) = rb0;
      *(uint4*)(nB + (tid + 256) * 8) = rb1;
    }
    __syncthreads();
  }
#pragma unroll
  for (int i = 0; i < 4; i++) {
    int row0 = mt * 128 + wm * 64 + i * 16 + fq * 4;
#pragma unroll
    for (int j = 0; j < 4; j++) {
      int col0 = nt * 128 + wn * 64 + j * 16;
      gemm_epi<MODE>(p, l, row0, col0, fr, acc[i][j], 0);
    }
    if (MODE == 1) {
      float* sq = (float*)(p.ws + OFF_SSQY);
#pragma unroll
      for (int jj = 0; jj < 4; jj++) {
        float s = 0.f;
#pragma unroll
        for (int j = 0; j < 4; j++) s += acc[i][j][jj] * acc[i][j][jj];
        s = sum16(s);
        if (fr == 0) sq[(size_t)(row0 + jj) * 16 + nt * 2 + wn] = s;
      }
    }
  }
}

__device__ __forceinline__ void mod_task(const Params& p, int task, char* smem) {
  float* sc = (float*)smem;
  float* sp = sc + 5 * 1024;
  const int tid = get_tid(), lane = tid & 63, w = tid >> 6;
  const int l = task / 48, cb = task % 48;
  __syncthreads();
  for (int i = tid; i < 5 * 1024; i += 256) {
    int b = i >> 10, k = i & 1023;
    float v = (b < 4) ? p.c[b * 1024 + k] : p.c_ctx[k];
    sc[i] = silu_f(v);
  }
  __syncthreads();
  const int col = cb * 64 + lane;
  const float* wp = p.w_mod + (size_t)l * 1024 * 3072 + (size_t)(w * 256) * 3072 + col;
  const float* scw = sc + w * 256;
  float a0 = 0, a1 = 0, a2 = 0, a3 = 0, a4 = 0;
#pragma unroll 16
  for (int k = 0; k < 256; k++) {
    float wv = wp[(size_t)k * 3072];
    a0 += scw[k] * wv;
    a1 += scw[1024 + k] * wv;
    a2 += scw[2048 + k] * wv;
    a3 += scw[3072 + k] * wv;
    a4 += scw[4096 + k] * wv;
  }
  sp[(w * 5 + 0) * 64 + lane] = a0;
  sp[(w * 5 + 1) * 64 + lane] = a1;
  sp[(w * 5 + 2) * 64 + lane] = a2;
  sp[(w * 5 + 3) * 64 + lane] = a3;
  sp[(w * 5 + 4) * 64 + lane] = a4;
  __syncthreads();
  for (int e = tid; e < 5 * 64; e += 256) {
    int b = e >> 6, cl = e & 63;
    int c2 = cb * 64 + cl;
    float v = sp[(0 * 5 + b) * 64 + cl] + sp[(1 * 5 + b) * 64 + cl] + sp[(2 * 5 + b) * 64 + cl] + sp[(3 * 5 + b) * 64 + cl] +
              p.b_mod[l * 3072 + c2];
    if (c2 >= 1024 && c2 < 2048) v = p.g_pre[l * 1024 + c2 - 1024] * (1.f + v);
    ((float*)(p.ws + OFF_MOD))[(size_t)(l * 5 + b) * 3072 + c2] = v;
  }
}

__device__ __forceinline__ void tables_task(const Params& p) {
  float* tab = (float*)(p.ws + OFF_TAB);
  for (int i = get_tid(); i < 4096; i += 256) {
    int n1 = i >> 6, k1 = i & 63;
    int m = (n1 * k1) & 63;
    float s, c;
    sincospif(2.f * (float)m / 64.f, &s, &c);
    tab[TAB_F64C + i] = c;
    tab[TAB_F64S + i] = s;
    sincospif(2.f * (float)i / 4096.f, &s, &c);
    tab[TAB_TWC + i] = c;
    tab[TAB_TWS + i] = s;
    if (i < 16) {
      int m4 = ((i >> 2) * (i & 3)) & 3;
      sincospif(2.f * (float)m4 / 4.f, &s, &c);
      tab[TAB_F4C + i] = c;
      tab[TAB_F4S + i] = s;
    }
  }
}

__device__ __forceinline__ void write_h(const Params& p, int l, int r, int lane, const float* xv, float rsv) {
  const int b5 = (r < NLAT) ? (r >> 12) : 4;
  const float* mv = (const float*)(p.ws + OFF_MOD) + (size_t)(l * 5 + b5) * 3072 + lane * 16;
  unsigned o[8];
#pragma unroll
  for (int i = 0; i < 4; i++) {
    float4 sh = *(const float4*)(mv + i * 4);
    float4 am = *(const float4*)(mv + 1024 + i * 4);
    o[i * 2 + 0] = pack2(xv[i * 4 + 0] * rsv * am.x + sh.x, xv[i * 4 + 1] * rsv * am.y + sh.y);
    o[i * 2 + 1] = pack2(xv[i * 4 + 2] * rsv * am.z + sh.z, xv[i * 4 + 3] * rsv * am.w + sh.w);
  }
  u16* hp = (u16*)(p.ws + OFF_H) + (size_t)r * 1024 + lane * 16;
  *(uint4*)hp = make_uint4(o[0], o[1], o[2], o[3]);
  *(uint4*)(hp + 8) = make_uint4(o[4], o[5], o[6], o[7]);
}

__device__ __forceinline__ void rowstat_task(const Params& p, int task) {
  const int tid = get_tid();
  const int lane = tid & 63, w = tid >> 6;
  const int r = task * 4 + w;
  const float* src = res_src(p, 0, r) + lane * 16;
  float xv[16];
  float s = 0.f;
#pragma unroll
  for (int i = 0; i < 4; i++) {
    float4 v = *(const float4*)(src + i * 4);
    xv[i * 4 + 0] = v.x; xv[i * 4 + 1] = v.y; xv[i * 4 + 2] = v.z; xv[i * 4 + 3] = v.w;
    s += v.x * v.x + v.y * v.y + v.z * v.z + v.w * v.w;
  }
  s = wave_sum(s);
  write_h(p, 0, r, lane, xv, rsqrtf(s * (1.f / 1024.f) + EPSV));
}

__device__ __forceinline__ void transpose_tile(const float* src, int src_ld, int src_col0, int nvalid, u16* dst, int dst_ld, int n0, int k0,
                               char* smem) {
  float* sT = (float*)smem;
  const int tid = get_tid();
  __syncthreads();
  {
    int nn = tid & 63, kq = tid >> 6;
#pragma unroll 4
    for (int i = 0; i < 16; i++) {
      int kk = kq + 4 * i;
      float v = (nn < nvalid) ? src[(size_t)(k0 + kk) * src_ld + src_col0 + nn] : 0.f;
      sT[nn * 65 + kk] = v;
    }
  }
  __syncthreads();
#pragma unroll
  for (int i = 0; i < 2; i++) {
    int id = tid + 256 * i;
    int nn = id >> 3, kc = id & 7;
    const float* s = sT + nn * 65 + kc * 8;
    uint4 o;
    o.x = pack2(s[0], s[1]);
    o.y = pack2(s[2], s[3]);
    o.z = pack2(s[4], s[5]);
    o.w = pack2(s[6], s[7]);
    *(uint4*)(dst + (size_t)(n0 + nn) * dst_ld + k0 + kc * 8) = o;
  }
}

__device__ __forceinline__ void wcs_task(const Params& p, int l, int task, char* smem) {
  float* sC = (float*)smem;
  const int tid = get_tid();
  const int h = task >> 7, c = task & 127;
  __syncthreads();
  if (tid < 128) {
    float s, co;
    sincospif(2.f * (float)((tid * c) & 127) / 128.f, &s, &co);
    sC[tid] = co;
    sC[128 + tid] = s;
  }
  __syncthreads();
  const float* wp = p.fnet_w + (size_t)l * 512 * 512 + (size_t)(h * 128) * 512;
  float r0 = 0, i0 = 0, r1 = 0, i1 = 0;
#pragma unroll 4
  for (int m = 0; m < 128; m++) {
    float w0 = wp[(size_t)m * 512 + tid], w1 = wp[(size_t)m * 512 + tid + 256];
    float co = sC[m], si = sC[128 + m];
    r0 += co * w0;
    i0 += si * w0;
    r1 += co * w1;
    i1 += si * w1;
  }
  const float sc = 0.08838834764831845f;
  u16* d = (u16*)(p.ws + OFF_WCST);
  d[(size_t)tid * 1024 + h * 128 + c] = f2bf(r0 * sc);
  d[(size_t)tid * 1024 + 512 + h * 128 + c] = f2bf(i0 * sc);
  d[(size_t)(tid + 256) * 1024 + h * 128 + c] = f2bf(r1 * sc);
  d[(size_t)(tid + 256) * 1024 + 512 + h * 128 + c] = f2bf(i1 * sc);
}

__device__ __forceinline__ void s5tab_task(const Params& p, int l, int g, char* smem) {
  float2* sAp = (float2*)smem;
  float2* sBb = sAp + 2 * 17 * 64;
  float2* sCc = sBb + 2 * 64 * 16;
  const int tid = get_tid();
  __syncthreads();
#pragma unroll 1
  for (int e = tid; e < 2 * 17 * 64; e += 256) {
    int d = e / (17 * 64), tau = (e / 64) % 17, pp = e & 63;
    int pi = ((l * 2 + d) * 32 + g) * 64 + pp;
    float step = expf(p.log_step[(l * 2 + d) * 32 + g]);
    float lr = p.lam_re[pi], li = p.lam_im[pi];
    float mag = expf(lr * step * (float)tau);
    float ang = li * step * (float)tau;
    sAp[e] = make_float2(mag * cosf(ang), mag * sinf(ang));
  }
#pragma unroll 1
  for (int e = tid; e < 2 * 64 * 16; e += 256) {
    int d = e >> 10, pp = (e >> 4) & 63, kk = e & 15;
    int pi = ((l * 2 + d) * 32 + g) * 64 + pp;
    float step = expf(p.log_step[(l * 2 + d) * 32 + g]);
    float lr = p.lam_re[pi], li = p.lam_im[pi];
    float mag = expf(lr * step);
    float ar = mag * cosf(li * step), ai = mag * sinf(li * step);
    float den = lr * lr + li * li;
    float fr_ = ((ar - 1.f) * lr + ai * li) / den;
    float fi_ = (ai * lr - (ar - 1.f) * li) / den;
    float br = p.b_re[(size_t)pi * 16 + kk], bi = p.b_im[(size_t)pi * 16 + kk];
    sBb[e] = make_float2(fr_ * br - fi_ * bi, fr_ * bi + fi_ * br);
  }
#pragma unroll 1
  for (int e = tid; e < 2 * 16 * 64; e += 256) {
    int d = e >> 10, kk = (e >> 6) & 15, pp = e & 63;
    size_t ci = ((size_t)((l * 2 + d) * 32 + g) * 16 + kk) * 64 + pp;
    sCc[e] = make_float2(p.c_re[ci], p.c_im[ci]);
  }
  __syncthreads();
  float* kt = (float*)(p.ws + OFF_KTAB) + (size_t)g * 8192;
#pragma unroll 1
  for (int e = tid; e < 8192; e += 256) {
    int d = e >> 12, tau = (e >> 8) & 15, k = (e >> 4) & 15, k2 = e & 15;
    float s = 0.f;
#pragma unroll 4
    for (int pp = 0; pp < 64; pp++) {
      float2 cc = sCc[(d * 16 + k) * 64 + pp];
      float2 ap = sAp[(d * 17 + tau) * 64 + pp];
      float2 bb = sBb[(d * 64 + pp) * 16 + k2];
      float cr = cc.x * ap.x - cc.y * ap.y, ci = cc.x * ap.y + cc.y * ap.x;
      s += cr * bb.x - ci * bb.y;
    }
    kt[e] = s;
  }
  __syncthreads();
  u16* TH = (u16*)(p.ws + OFF_S5TH) + (size_t)g * 256 * 512;
#pragma unroll 2
  for (int e = tid; e < 256 * 512; e += 256) {
    int row = e >> 9, col = e & 511;
    int i = row >> 4, k = row & 15;
    float v;
    if (col < 256) {
      int j = col >> 4, k2 = col & 15;
      v = 0.f;
      if (j <= i) v += kt[(0 * 16 + (i - j)) * 256 + k * 16 + k2];
      if (j >= i) v += kt[(1 * 16 + (j - i)) * 256 + k * 16 + k2];
      if (i == j && k == k2) v += p.s5_d[l * 512 + g * 16 + k];
    } else {
      int q = col - 256;
      int d = q >> 7, ri = (q >> 6) & 1, pp = q & 63;
      int pw = (d == 0) ? (i + 1) : (16 - i);
      float2 cc = sCc[(d * 16 + k) * 64 + pp];
      float2 ap = sAp[(d * 17 + pw) * 64 + pp];
      float cr = cc.x * ap.x - cc.y * ap.y, ci = cc.x * ap.y + cc.y * ap.x;
      v = (ri == 0) ? cr : -ci;
    }
    TH[e] = f2bf(v);
  }
  u16* M1 = (u16*)(p.ws + OFF_S5M1) + (size_t)g * 256 * 256;
#pragma unroll 2
  for (int e = tid; e < 256 * 256; e += 256) {
    int row = e >> 8, col = e & 255;
    int d = row >> 7, ri = (row >> 6) & 1, pp = row & 63;
    int j = col >> 4, k2 = col & 15;
    int ex = (d == 0) ? (15 - j) : j;
    float2 ap = sAp[(d * 17 + ex) * 64 + pp];
    float2 bb = sBb[(d * 64 + pp) * 16 + k2];
    float v = (ri == 0) ? (ap.x * bb.x - ap.y * bb.y) : (ap.x * bb.y + ap.y * bb.x);
    M1[e] = f2bf(v);
  }
}

#define PREP_TASKS (32 + 1184 + 512 + 64 + 512)
__device__ __forceinline__ void prep_task(const Params& p, int l, int t, char* smem) {
  if (t < 32) {
    s5tab_task(p, l, t, smem);
    return;
  }
  t -= 32;
  if (t < 1184) {
    int nb = t / 16, kb = t % 16;
    int n0 = nb * 64;
    int src_col0, nvalid = 64;
    if (n0 < 2560) src_col0 = n0;
    else if (n0 < 4608) src_col0 = n0 + 32;
    else if (n0 < 4640) { src_col0 = n0 - 2048; nvalid = 32; }
    else { src_col0 = 0; nvalid = 0; }
    transpose_tile(p.w_in + (size_t)l * 1024 * DIN, DIN, src_col0, nvalid, (u16*)(p.ws + OFF_WINT), 1024, n0, kb * 64, smem);
    return;
  }
  t -= 1184;
  if (t < 512) {
    int nb = t / 32, kb = t % 32;
    transpose_tile(p.w_out + (size_t)l * 2048 * 1024, 1024, nb * 64, 64, (u16*)(p.ws + OFF_WOUTT), 2048, nb * 64, kb * 64, smem);
    return;
  }
  t -= 512;
  if (t < 64) {
    int nb = t / 8, kb = t % 8;
    transpose_tile(p.w_glu + (size_t)l * 512 * 512, 512, nb * 64, 64, (u16*)(p.ws + OFF_GLUT), 512, nb * 64, kb * 64, smem);
    return;
  }
  t -= 64;
  wcs_task(p, l, t, smem);
}

__device__ __forceinline__ void conv_task(const Params& p, int l, int task, char* smem) {
  float* sOut = (float*)smem;
  const int tid = get_tid();
  const int gc = task / 24, cb = task % 24;
  const int cg8 = tid & 7, tk = tid >> 3;
  const int ch = cb * 64 + cg8 * 8;
  const u16* raw = (const u16*)(p.ws + OFF_RAW);
  float acc[4][8];
  {
    const float* bp = p.conv_b + l * 1536 + ch;
    float4 b0 = *(const float4*)bp, b1 = *(const float4*)(bp + 4);
#pragma unroll
    for (int q = 0; q < 4; q++) {
      acc[q][0] = b0.x; acc[q][1] = b0.y; acc[q][2] = b0.z; acc[q][3] = b0.w;
      acc[q][4] = b1.x; acc[q][5] = b1.y; acc[q][6] = b1.z; acc[q][7] = b1.w;
    }
  }
  const bool isctx = gc >= 128;
  const int b = isctx ? ((gc - 128) >> 1) : (gc >> 5);
  const int tbase = isctx ? ((gc - 128) & 1) * 128 : (gc & 31) * 128;
  const size_t rowbase = isctx ? (size_t)(NLAT + b * 256) : (size_t)(b * 4096);
#pragma unroll
  for (int tap = 0; tap < 9; tap++) {
    const int di = tap / 3 - 1, dj = tap % 3 - 1;
    if (isctx && di != 0) continue;
    const float* wp = p.conv_w + (size_t)(l * 9 + tap) * 1536 + ch;
    float4 w0 = *(const float4*)wp, w1 = *(const float4*)(wp + 4);
#pragma unroll
    for (int q = 0; q < 4; q++) {
      const int t = tbase + tk + q * 32;
      bool ok;
      int tt;
      if (!isctx) {
        int rr = (t >> 6) + di, cc = (t & 63) + dj;
        ok = (rr >= 0) && (rr < 64) && (cc >= 0) && (cc < 64);
        tt = rr * 64 + cc;
      } else {
        tt = t + dj;
        ok = (tt >= 0) && (tt < 256);
      }
      if (ok) {
        uint4 v = *(const uint4*)(raw + (rowbase + tt) * 1536 + ch);
        acc[q][0] += w0.x * lo16(v.x); acc[q][1] += w0.y * hi16(v.x);
        acc[q][2] += w0.z * lo16(v.y); acc[q][3] += w0.w * hi16(v.y);
        acc[q][4] += w1.x * lo16(v.z); acc[q][5] += w1.y * hi16(v.z);
        acc[q][6] += w1.z * lo16(v.w); acc[q][7] += w1.w * hi16(v.w);
      }
    }
  }
  __syncthreads();
#pragma unroll
  for (int q = 0; q < 4; q++) {
    float* so = sOut + (tk + q * 32) * 65 + cg8 * 8;
#pragma unroll
    for (int j = 0; j < 8; j++) so[j] = silu_f(acc[q][j]);
  }
  __syncthreads();
  if (cb < 16) {
    u16* XT = (u16*)(p.ws + OFF_XT);
#pragma unroll
    for (int i = 0; i < 4; i++) {
      int id = tid + 256 * i;
      int chl = id >> 4, tc = id & 15;
      const float* s = sOut + (tc * 8) * 65 + chl;
      uint4 o;
      o.x = pack2(s[0], s[65]);
      o.y = pack2(s[130], s[195]);
      o.z = pack2(s[260], s[325]);
      o.w = pack2(s[390], s[455]);
      *(uint4*)(XT + ((size_t)gc * 1024 + cb * 64 + chl) * 128 + tc * 8) = o;
    }
  } else {
    u16* dst = (u16*)(p.ws + (cb < 20 ? OFF_BN : OFF_CN));
    const int c0 = (cb < 20 ? cb - 16 : cb - 20) * 64;
#pragma unroll
    for (int i = 0; i < 4; i++) {
      int id = tid + 256 * i;
      int tok = id >> 3, cc = id & 7;
      const float* s = sOut + tok * 65 + cc * 8;
      uint4 o;
      o.x = pack2(s[0], s[1]);
      o.y = pack2(s[2], s[3]);
      o.z = pack2(s[4], s[5]);
      o.w = pack2(s[6], s[7]);
      *(uint4*)(dst + (size_t)(gc * 128 + tok) * 256 + c0 + cc * 8) = o;
    }
  }
}

template <int N1>
__device__ __forceinline__ void fft1_task(const Params& p, int rowbase, int n2, int cb, char* smem) {
  float* sX = (float*)smem;
  const int tid = get_tid(), c = tid & 63;
  const int wq = __builtin_amdgcn_readfirstlane(tid >> 6);
  u16* fu = (u16*)(p.ws + OFF_FU);
  u16* fi = (u16*)(p.ws + OFF_FIM);
  const float* tab = (const float*)(p.ws + OFF_TAB);
  __syncthreads();
  for (int n1 = wq; n1 < N1; n1 += 4) sX[n1 * 64 + c] = bf2f(fu[(size_t)(rowbase + n1 * 64 + n2) * 512 + cb * 64 + c]);
  __syncthreads();
  constexpr int KPW = N1 / 4;
  const float* Fc = tab + (N1 == 64 ? TAB_F64C : TAB_F4C);
  const float* Fs = tab + (N1 == 64 ? TAB_F64S : TAB_F4S);
  float re[KPW], im[KPW];
#pragma unroll
  for (int i = 0; i < KPW; i++) re[i] = 0.f, im[i] = 0.f;
  for (int n1 = 0; n1 < N1; n1++) {
    float xv = sX[n1 * 64 + c];
#pragma unroll
    for (int i = 0; i < KPW; i++) {
      re[i] += xv * Fc[n1 * N1 + wq * KPW + i];
      im[i] -= xv * Fs[n1 * N1 + wq * KPW + i];
    }
  }
#pragma unroll
  for (int i = 0; i < KPW; i++) {
    int k1 = wq * KPW + i;
    int idx = (k1 * n2 * (64 / N1)) & 4095;
    float tc = tab[TAB_TWC + idx], ts = tab[TAB_TWS + idx];
    float r2 = re[i] * tc + im[i] * ts;
    float i2 = im[i] * tc - re[i] * ts;
    size_t o = (size_t)(rowbase + k1 * 64 + n2) * 512 + cb * 64 + c;
    fu[o] = f2bf(r2);
    fi[o] = f2bf(i2);
  }
}

__device__ __forceinline__ void fft2_task(const Params& p, int rowbase, int cb, float scale, char* smem) {
  float* sR = (float*)smem;
  float* sI = sR + 4096;
  const int tid = get_tid(), c = tid & 63;
  const int wq = __builtin_amdgcn_readfirstlane(tid >> 6);
  u16* fu = (u16*)(p.ws + OFF_FU);
  u16* fi = (u16*)(p.ws + OFF_FIM);
  const float* tab = (const float*)(p.ws + OFF_TAB);
  __syncthreads();
  for (int n2 = wq; n2 < 64; n2 += 4) {
    size_t o = (size_t)(rowbase + n2) * 512 + cb * 64 + c;
    sR[n2 * 64 + c] = bf2f(fu[o]);
    sI[n2 * 64 + c] = bf2f(fi[o]);
  }
  __syncthreads();
  const float* Fc = tab + TAB_F64C;
  const float* Fs = tab + TAB_F64S;
  float re[16], im[16];
#pragma unroll
  for (int i = 0; i < 16; i++) re[i] = 0.f, im[i] = 0.f;
  for (int n2 = 0; n2 < 64; n2++) {
    float xr = sR[n2 * 64 + c], xi = sI[n2 * 64 + c];
#pragma unroll
    for (int i = 0; i < 16; i++) {
      float fc = Fc[n2 * 64 + wq * 16 + i], fs = Fs[n2 * 64 + wq * 16 + i];
      re[i] += xr * fc + xi * fs;
      im[i] += xi * fc - xr * fs;
    }
  }
#pragma unroll
  for (int i = 0; i < 16; i++) {
    int k2 = wq * 16 + i;
    size_t o = (size_t)(rowbase + k2) * 512 + cb * 64 + c;
    fu[o] = f2bf(re[i] * scale);
    fi[o] = f2bf(im[i] * scale);
  }
}

template <bool P3>
__device__ __forceinline__ void s5_gemm_task(const Params& p, int task) {
  const int g = task / 17, cbk = task % 17;
  const int tid = get_tid(), lane = tid & 63, w = tid >> 6, fr = lane & 15, fq = lane >> 4;
  constexpr int LDA = P3 ? 512 : 256;
  constexpr int KT = P3 ? 16 : 8;
  const u16* Am = (const u16*)(p.ws + (P3 ? OFF_S5TH : OFF_S5M1)) + (size_t)g * 256 * LDA;
  u16* s5u = (u16*)(p.ws + OFF_S5U);
  u16* st = (u16*)(p.ws + OFF_S5ST);
  f32x4 acc[4][4];
#pragma unroll
  for (int i = 0; i < 4; i++)
#pragma unroll
    for (int j = 0; j < 4; j++) acc[i][j] = f32x4{0.f, 0.f, 0.f, 0.f};
  for (int ks = 0; ks < KT; ks++) {
    const int k0 = ks * 32 + fq * 8;
    bf16x8 af[4], bfr[4];
#pragma unroll
    for (int i = 0; i < 4; i++) af[i] = *(const bf16x8*)(Am + (size_t)(w * 64 + i * 16 + fr) * LDA + k0);
#pragma unroll
    for (int j = 0; j < 4; j++) {
      int cidx = cbk * 64 + j * 16 + fr;
      if (ks < 8) bfr[j] = *(const bf16x8*)(s5u + ((size_t)g * NTOK + cidx * 16) * 16 + k0);
      else bfr[j] = *(const bf16x8*)(st + ((size_t)cidx * 32 + g) * 256 + (k0 - 256));
    }
#pragma unroll
    for (int i = 0; i < 4; i++)
#pragma unroll
      for (int j = 0; j < 4; j++) acc[i][j] = __builtin_amdgcn_mfma_f32_16x16x32_bf16(af[i], bfr[j], acc[i][j], 0, 0, 0);
  }
  if (P3) __syncthreads();
#pragma unroll
  for (int i = 0; i < 4; i++) {
    int row = w * 64 + i * 16 + fq * 4;
#pragma unroll
    for (int j = 0; j < 4; j++) {
      int cidx = cbk * 64 + j * 16 + fr;
      uint2 o;
      if (P3) {
        o.x = pack2(gelu_tanh(acc[i][j][0]), gelu_tanh(acc[i][j][1]));
        o.y = pack2(gelu_tanh(acc[i][j][2]), gelu_tanh(acc[i][j][3]));
        *(uint2*)(s5u + ((size_t)g * NTOK + cidx * 16 + (row >> 4)) * 16 + (row & 15)) = o;
      } else {
        o.x = pack2(acc[i][j][0], acc[i][j][1]);
        o.y = pack2(acc[i][j][2], acc[i][j][3]);
        *(uint2*)(st + ((size_t)cidx * 32 + g) * 256 + row) = o;
      }
    }
  }
  if (P3) __syncthreads();
}

__device__ __forceinline__ void s5_scan_task(const Params& p, int l, int task) {
  const int idx = task * 256 + get_tid();
  const int pp = idx & 63, d = (idx >> 6) & 1, g = (idx >> 7) & 31, b = idx >> 12;
  const int pi = ((l * 2 + d) * 32 + g) * 64 + pp;
  const float step = expf(p.log_step[(l * 2 + d) * 32 + g]);
  const float lr = p.lam_re[pi], li = p.lam_im[pi];
  const float mag = expf(lr * step * 16.f);
  const float ar = mag * cosf(li * step * 16.f), ai = mag * sinf(li * step * 16.f);
  u16* st = (u16*)(p.ws + OFF_S5ST);
  float hr = 0.f, hi = 0.f;
  for (int s0 = 0; s0 < 272; s0 += 16) {
    float vr[16], vi[16];
    u16* ptr[16];
#pragma unroll
    for (int i = 0; i < 16; i++) {
      int s = s0 + i;
      int cidx;
      if (d == 0) cidx = (s < 16) ? (1024 + b * 16 + s) : (b * 256 + (s - 16));
      else cidx = (s < 16) ? (1024 + b * 16 + (15 - s)) : (b * 256 + 255 - (s - 16));
      ptr[i] = st + ((size_t)cidx * 32 + g) * 256 + d * 128 + pp;
      vr[i] = bf2f(ptr[i][0]);
      vi[i] = bf2f(ptr[i][64]);
    }
#pragma unroll
    for (int i = 0; i < 16; i++) {
      ptr[i][0] = f2bf(hr);
      ptr[i][64] = f2bf(hi);
      float nr = ar * hr - ai * hi + vr[i];
      float ni = ar * hi + ai * hr + vi[i];
      hr = nr;
      hi = ni;
    }
  }
}

__device__ __forceinline__ void ssd_acum(const Params& p, int l, int gc, int h, float* sA_, float* sDt, float* sAc) {
  const int tid = get_tid();
  const int d = tid >> 7, j = tid & 127;
  const float* dt = (const float*)(p.ws + OFF_DT);
  float dtv = dt[(size_t)(gc * 128 + j) * 32 + d * 16 + h];
  float aneg = -expf(p.a_log[l * 32 + d * 16 + h]);
  sA_[tid] = dtv * aneg;
  sDt[tid] = dtv;
  __syncthreads();
  float s = 0.f;
  if (d == 0) {
    for (int k = 0; k <= j; k++) s += sA_[k];
  } else {
    for (int k = 127; k >= j; k--) s += sA_[128 + k];
  }
  sAc[tid] = s;
  __syncthreads();
}

__device__ __forceinline__ void ssd_p1_task(const Params& p, int l, int task, char* smem) {
  const int gc = task >> 4, h = task & 15, g = h >> 3;
  u16* sBT = (u16*)smem;
  float* sA_ = (float*)(smem + 128 * 136 * 2);
  float* sDt = sA_ + 256;
  float* sAc = sDt + 256;
  float* sW = sAc + 256;
  const int tid = get_tid(), lane = tid & 63, w = tid >> 6, fr = lane & 15, fq = lane >> 4;
  __syncthreads();
  ssd_acum(p, l, gc, h, sA_, sDt, sAc);
  {
    int d = tid >> 7, j = tid & 127;
    float tot = (d == 0) ? sAc[127] : sAc[128];
    sW[tid] = sDt[tid] * __expf(tot - sAc[tid]);
    if (j == 0) ((float*)(p.ws + OFF_CDEC))[(gc * 16 + h) * 2 + d] = __expf(tot);
  }
  const u16* BN = (const u16*)(p.ws + OFF_BN);
#pragma unroll
  for (int i = 0; i < 8; i++) {
    int id = tid + 256 * i;
    int j = id >> 4, nc = id & 15;
    uint4 v = *(const uint4*)(BN + (size_t)(gc * 128 + j) * 256 + g * 128 + nc * 8);
    u16* d0 = sBT + (nc * 8) * 136 + j;
    d0[0] = (u16)(v.x & 0xffff); d0[136] = (u16)(v.x >> 16);
    d0[272] = (u16)(v.y & 0xffff); d0[408] = (u16)(v.y >> 16);
    d0[544] = (u16)(v.z & 0xffff); d0[680] = (u16)(v.z >> 16);
    d0[816] = (u16)(v.w & 0xffff); d0[952] = (u16)(v.w >> 16);
  }
  __syncthreads();
  const u16* XT = (const u16*)(p.ws + OFF_XT) + ((size_t)gc * 1024 + h * 64 + w * 16 + fr) * 128;
  f32x4 accf[8], accb[8];
#pragma unroll
  for (int i = 0; i < 8; i++) accf[i] = f32x4{0.f, 0.f, 0.f, 0.f}, accb[i] = f32x4{0.f, 0.f, 0.f, 0.f};
#pragma unroll
  for (int ks = 0; ks < 4; ks++) {
    const int k0 = ks * 32 + fq * 8;
    uint4 xv = *(const uint4*)(XT + k0);
    float xf[8] = {lo16(xv.x), hi16(xv.x), lo16(xv.y), hi16(xv.y), lo16(xv.z), hi16(xv.z), lo16(xv.w), hi16(xv.w)};
    uint4 af, ab;
    af.x = pack2(xf[0] * sW[k0 + 0], xf[1] * sW[k0 + 1]);
    af.y = pack2(xf[2] * sW[k0 + 2], xf[3] * sW[k0 + 3]);
    af.z = pack2(xf[4] * sW[k0 + 4], xf[5] * sW[k0 + 5]);
    af.w = pack2(xf[6] * sW[k0 + 6], xf[7] * sW[k0 + 7]);
    ab.x = pack2(xf[0] * sW[128 + k0 + 0], xf[1] * sW[128 + k0 + 1]);
    ab.y = pack2(xf[2] * sW[128 + k0 + 2], xf[3] * sW[128 + k0 + 3]);
    ab.z = pack2(xf[4] * sW[128 + k0 + 4], xf[5] * sW[128 + k0 + 5]);
    ab.w = pack2(xf[6] * sW[128 + k0 + 6], xf[7] * sW[128 + k0 + 7]);
    bf16x8 fa = as_frag(af), fb = as_frag(ab);
#pragma unroll
    for (int nf = 0; nf < 8; nf++) {
      bf16x8 bfr = *(const bf16x8*)(sBT + (nf * 16 + fr) * 136 + k0);
      accf[nf] = __builtin_amdgcn_mfma_f32_16x16x32_bf16(fa, bfr, accf[nf], 0, 0, 0);
      accb[nf] = __builtin_amdgcn_mfma_f32_16x16x32_bf16(fb, bfr, accb[nf], 0, 0, 0);
    }
  }
  u16* st = (u16*)(p.ws + OFF_ST) + (size_t)(gc * 16 + h) * 2 * 8192;
#pragma unroll
  for (int nf = 0; nf < 8; nf++) {
#pragma unroll
    for (int j = 0; j < 4; j++) {
      int pr = w * 16 + fq * 4 + j, n = nf * 16 + fr;
      st[(size_t)pr * 128 + n] = f2bf(accf[nf][j]);
      st[8192 + (size_t)pr * 128 + n] = f2bf(accb[nf][j]);
    }
  }
}

__device__ __forceinline__ void ssd_p2_task(const Params& p, int task) {
  const int e = task * 256 + get_tid();
  const int pn = e & 8191, d = (e >> 13) & 1, h = (e >> 14) & 15, b = e >> 18;
  u16* st = (u16*)(p.ws + OFF_ST) + (size_t)(h * 2 + d) * 8192 + pn;
  const float* cdec = (const float*)(p.ws + OFF_CDEC) + h * 2 + d;
  float hs = 0.f;
#pragma unroll 1
  for (int s0 = 0; s0 < 34; s0 += 17) {
    float v[17], dc[17];
#pragma unroll
    for (int i = 0; i < 17; i++) {
      int s = s0 + i, gc;
      if (d == 0) gc = (s < 2) ? (128 + 2 * b + s) : (32 * b + (s - 2));
      else gc = (s < 2) ? (128 + 2 * b + (1 - s)) : (32 * b + 31 - (s - 2));
      v[i] = bf2f(st[(unsigned)gc * (16u * 2u * 8192u)]);
      dc[i] = cdec[gc * 32];
    }
#pragma unroll
    for (int i = 0; i < 17; i++) {
      int s = s0 + i, gc;
      if (d == 0) gc = (s < 2) ? (128 + 2 * b + s) : (32 * b + (s - 2));
      else gc = (s < 2) ? (128 + 2 * b + (1 - s)) : (32 * b + 31 - (s - 2));
      st[(unsigned)gc * (16u * 2u * 8192u)] = f2bf(hs);
      hs = hs * dc[i] + v[i];
    }
  }
}

__device__ __forceinline__ void ssd_p3_task(const Params& p, int l, int task, char* smem) {
  const int gc = task >> 4, h = task & 15, g = h >> 3;
  u16* sM = (u16*)smem;
  float* sA_ = (float*)(smem + 2 * 128 * 136 * 2);
  float* sDt = sA_ + 256;
  float* sAc = sDt + 256;
  const int tid = get_tid(), lane = tid & 63, w = tid >> 6, fr = lane & 15, fq = lane >> 4;
  __syncthreads();
  ssd_acum(p, l, gc, h, sA_, sDt, sAc);
  const u16* BN = (const u16*)(p.ws + OFF_BN) + (size_t)(gc * 128) * 256 + g * 128;
  const u16* CN = (const u16*)(p.ws + OFF_CN) + (size_t)(gc * 128) * 256 + g * 128;
  const u16* XT = (const u16*)(p.ws + OFF_XT) + ((size_t)gc * 1024 + h * 64) * 128;
  {
    f32x4 G[2][8];
#pragma unroll
    for (int a = 0; a < 2; a++)
#pragma unroll
      for (int c = 0; c < 8; c++) G[a][c] = f32x4{0.f, 0.f, 0.f, 0.f};
#pragma unroll
    for (int ks = 0; ks < 4; ks++) {
      const int k0 = ks * 32 + fq * 8;
      bf16x8 af[2];
#pragma unroll
      for (int a = 0; a < 2; a++) af[a] = *(const bf16x8*)(BN + (size_t)(w * 32 + a * 16 + fr) * 256 + k0);
#pragma unroll
      for (int c = 0; c < 8; c++) {
        bf16x8 bfr = *(const bf16x8*)(CN + (size_t)(c * 16 + fr) * 256 + k0);
#pragma unroll
        for (int a = 0; a < 2; a++) G[a][c] = __builtin_amdgcn_mfma_f32_16x16x32_bf16(af[a], bfr, G[a][c], 0, 0, 0);
      }
    }
#pragma unroll
    for (int a = 0; a < 2; a++) {
      const int j0 = w * 32 + a * 16 + fq * 4;
      const float fj0 = sAc[j0], fj1 = sAc[j0 + 1], fj2 = sAc[j0 + 2], fj3 = sAc[j0 + 3];
      const float bj0 = sAc[128 + j0], bj1 = sAc[128 + j0 + 1], bj2 = sAc[128 + j0 + 2], bj3 = sAc[128 + j0 + 3];
#pragma unroll
      for (int c = 0; c < 8; c++) {
        const int i = c * 16 + fr;
        const float fi = sAc[i], bi = sAc[128 + i];
        float m0 = (j0 + 0 <= i) ? G[a][c][0] * __expf(fi - fj0) : 0.f;
        float m1 = (j0 + 1 <= i) ? G[a][c][1] * __expf(fi - fj1) : 0.f;
        float m2 = (j0 + 2 <= i) ? G[a][c][2] * __expf(fi - fj2) : 0.f;
        float m3 = (j0 + 3 <= i) ? G[a][c][3] * __expf(fi - fj3) : 0.f;
        uint2 o;
        o.x = pack2(m0, m1);
        o.y = pack2(m2, m3);
        *(uint2*)(sM + i * 136 + j0) = o;
        m0 = (j0 + 0 >= i) ? G[a][c][0] * __expf(bi - bj0) : 0.f;
        m1 = (j0 + 1 >= i) ? G[a][c][1] * __expf(bi - bj1) : 0.f;
        m2 = (j0 + 2 >= i) ? G[a][c][2] * __expf(bi - bj2) : 0.f;
        m3 = (j0 + 3 >= i) ? G[a][c][3] * __expf(bi - bj3) : 0.f;
        o.x = pack2(m0, m1);
        o.y = pack2(m2, m3);
        *(uint2*)(sM + 128 * 136 + i * 136 + j0) = o;
      }
    }
  }
  __syncthreads();
  f32x4 acc[2][4];
#pragma unroll
  for (int a = 0; a < 2; a++)
#pragma unroll
    for (int c = 0; c < 4; c++) acc[a][c] = f32x4{0.f, 0.f, 0.f, 0.f};

#pragma unroll
  for (int d = 0; d < 2; d++) {
    const float* ac = sAc + d * 128;
    const float* dtp = sDt + d * 128;
    const u16* sMd = sM + d * 128 * 136;
    for (int ks = 0; ks < 4; ks++) {
      if (d == 0 ? (ks > w) : (ks < w)) continue;
      const int k0 = ks * 32 + fq * 8;
      bf16x8 af[2];
#pragma unroll
      for (int a = 0; a < 2; a++) af[a] = *(const bf16x8*)(sMd + (w * 32 + a * 16 + fr) * 136 + k0);
#pragma unroll
      for (int c = 0; c < 4; c++) {
        uint4 xv = *(const uint4*)(XT + (size_t)(c * 16 + fr) * 128 + k0);
        uint4 xb;
        xb.x = pack2(lo16(xv.x) * dtp[k0 + 0], hi16(xv.x) * dtp[k0 + 1]);
        xb.y = pack2(lo16(xv.y) * dtp[k0 + 2], hi16(xv.y) * dtp[k0 + 3]);
        xb.z = pack2(lo16(xv.z) * dtp[k0 + 4], hi16(xv.z) * dtp[k0 + 5]);
        xb.w = pack2(lo16(xv.w) * dtp[k0 + 6], hi16(xv.w) * dtp[k0 + 7]);
        bf16x8 bfr = as_frag(xb);
#pragma unroll
        for (int a = 0; a < 2; a++) acc[a][c] = __builtin_amdgcn_mfma_f32_16x16x32_bf16(af[a], bfr, acc[a][c], 0, 0, 0);
      }
    }
    f32x4 tmp[2][4];
#pragma unroll
    for (int a = 0; a < 2; a++)
#pragma unroll
      for (int c = 0; c < 4; c++) tmp[a][c] = f32x4{0.f, 0.f, 0.f, 0.f};
    const u16* hin = (const u16*)(p.ws + OFF_ST) + ((size_t)(gc * 16 + h) * 2 + d) * 8192;
#pragma unroll
    for (int ks = 0; ks < 4; ks++) {
      const int k0 = ks * 32 + fq * 8;
      bf16x8 af[2];
#pragma unroll
      for (int a = 0; a < 2; a++) af[a] = *(const bf16x8*)(CN + (size_t)(w * 32 + a * 16 + fr) * 256 + k0);
#pragma unroll
      for (int c = 0; c < 4; c++) {
        bf16x8 bfr = *(const bf16x8*)(hin + (size_t)(c * 16 + fr) * 128 + k0);
#pragma unroll
        for (int a = 0; a < 2; a++) tmp[a][c] = __builtin_amdgcn_mfma_f32_16x16x32_bf16(af[a], bfr, tmp[a][c], 0, 0, 0);
      }
    }
#pragma unroll
    for (int a = 0; a < 2; a++) {
      const int i0 = w * 32 + a * 16 + fq * 4;
      float e0 = __expf(ac[i0]), e1 = __expf(ac[i0 + 1]), e2 = __expf(ac[i0 + 2]), e3 = __expf(ac[i0 + 3]);
#pragma unroll
      for (int c = 0; c < 4; c++) {
        acc[a][c][0] += tmp[a][c][0] * e0;
        acc[a][c][1] += tmp[a][c][1] * e1;
        acc[a][c][2] += tmp[a][c][2] * e2;
        acc[a][c][3] += tmp[a][c][3] * e3;
      }
    }
  }
  const float dsk = p.d_ssd[l * 16 + h];
  u16* z = (u16*)(p.ws + OFF_Z);
  float* ssq = (float*)(p.ws + OFF_SSQV);
#pragma unroll
  for (int a = 0; a < 2; a++) {
    const int i0 = w * 32 + a * 16 + fq * 4;
    float sq[4] = {0.f, 0.f, 0.f, 0.f};
#pragma unroll
    for (int c = 0; c < 4; c++) {
      const int pc = c * 16 + fr;
      uint2 xv = *(const uint2*)(XT + (size_t)pc * 128 + i0);
      float xs[4] = {lo16(xv.x), hi16(xv.x), lo16(xv.y), hi16(xv.y)};
#pragma unroll
      for (int j = 0; j < 4; j++) {
        size_t zi = (size_t)(gc * 128 + i0 + j) * 1024 + h * 64 + pc;
        float zv = bf2f(z[zi]);
        float y = acc[a][c][j] + dsk * xs[j];
        float v = y * silu_f(zv);
        z[zi] = f2bf(v);
        sq[j] += v * v;
      }
    }
#pragma unroll
    for (int j = 0; j < 4; j++) {
      float s = sum16(sq[j]);
      if (fr == 0) ssq[(size_t)(gc * 128 + i0 + j) * 16 + h] = s;
    }
  }
}

__device__ __forceinline__ void resid_task(const Params& p, int l, int task) {
  const int tid = get_tid();
  const int lane = tid & 63, w = tid >> 6;
  const int r = task * 4 + w;
  if (l == NLAYER - 1 && r >= NLAT) return;
  const int b5 = (r < NLAT) ? (r >> 12) : 4;
  const int k0 = lane * 16;
  const float* sq = (const float*)(p.ws + OFF_SSQY) + (size_t)r * 16;
  float s = 0.f;
#pragma unroll
  for (int i = 0; i < 4; i++) {
    float4 q = *(const float4*)(sq + i * 4);
    s += q.x + q.y + q.z + q.w;
  }
  const float rsy = rsqrtf(s * (1.f / 1024.f) + EPSV);
  const u16* y = (const u16*)(p.ws + OFF_FU) + (size_t)r * 1024 + k0;
  uint4 y0 = *(const uint4*)y, y1 = *(const uint4*)(y + 8);
  float yv[16] = {lo16(y0.x), hi16(y0.x), lo16(y0.y), hi16(y0.y), lo16(y0.z), hi16(y0.z), lo16(y0.w), hi16(y0.w),
                  lo16(y1.x), hi16(y1.x), lo16(y1.y), hi16(y1.y), lo16(y1.z), hi16(y1.z), lo16(y1.w), hi16(y1.w)};
  const float* gate = (const float*)(p.ws + OFF_MOD) + (size_t)(l * 5 + b5) * 3072 + 2048 + k0;
  const float* gp = p.g_post + l * 1024 + k0;
  const float* src = res_src(p, l, r) + k0;
  float* dst = ((r < NLAT) ? p.out + (size_t)r * DM : (float*)(p.ws + OFF_XC) + (size_t)(r - NLAT) * DM) + k0;
  float ss = 0.f;
  float xn[16];
#pragma unroll
  for (int i = 0; i < 4; i++) {
    float4 xo = *(const float4*)(src + i * 4);
    float4 gt = *(const float4*)(gate + i * 4);
    float4 gq = *(const float4*)(gp + i * 4);
    float4 o;
    o.x = xo.x + gt.x * (yv[i * 4 + 0] * rsy * gq.x);
    o.y = xo.y + gt.y * (yv[i * 4 + 1] * rsy * gq.y);
    o.z = xo.z + gt.z * (yv[i * 4 + 2] * rsy * gq.z);
    o.w = xo.w + gt.w * (yv[i * 4 + 3] * rsy * gq.w);
    *(float4*)(dst + i * 4) = o;
    xn[i * 4 + 0] = o.x; xn[i * 4 + 1] = o.y; xn[i * 4 + 2] = o.z; xn[i * 4 + 3] = o.w;
    ss += o.x * o.x + o.y * o.y + o.z * o.z + o.w * o.w;
  }
  if (l < NLAYER - 1) {
    ss = wave_sum(ss);
    write_h(p, l + 1, r, lane, xn, rsqrtf(ss * (1.f / 1024.f) + EPSV));
  }
}

__device__ __forceinline__ void run_phase(const Params& p, int ph, char* smem) {
  const int nb = gridDim.x, b0 = blockIdx.x;
  if (ph == 0) {
    const int total = 192 + 1 + PREP_TASKS;
    for (int t = b0; t < total; t += nb) {
      if (t < 32) prep_task(p, 0, t, smem);
      else if (t < 32 + 192) mod_task(p, t - 32, smem);
      else if (t < 32 + 192 + 1) tables_task(p);
      else prep_task(p, 0, t - 193, smem);
    }
    return;
  }
  if (ph == 1) {
    for (int t = b0; t < 4352; t += nb) rowstat_task(p, t);
    return;
  }
  const int l = (ph - 2) / 7, s = (ph - 2) % 7;
  const bool last = (l == NLAYER - 1);
  if (s == 0) {
    for (int t = b0; t < 136 * 37; t += nb) gemm_tile<0>(p, l, t / 37, t % 37, smem);
  } else if (s == 1) {
    const int total = 544 + 3264 + 2048 + 2048;
    for (int t = b0; t < total; t += nb) {
      if (t < 544) s5_gemm_task<false>(p, t);
      else if (t < 544 + 3264) conv_task(p, l, t - 544, smem);
      else if (t < 544 + 3264 + 2048) {
        int q = t - 544 - 3264;
        int b = q >> 9, n2 = (q >> 3) & 63, cb = q & 7;
        fft1_task<64>(p, b * 4096, n2, cb, smem);
      } else {
        int q = t - 544 - 3264 - 2048;
        int b = q >> 9, n2 = (q >> 3) & 63, cb = q & 7;
        if (!last) fft1_task<4>(p, NLAT + b * 256, n2, cb, smem);
      }
    }
  } else if (s == 2) {
    const int total = 64 + 2176 + 2048 + 128;
    for (int t = b0; t < total; t += nb) {
      if (t < 64) s5_scan_task(p, l, t);
      else if (t < 64 + 2176) ssd_p1_task(p, l, t - 64, smem);
      else if (t < 64 + 2176 + 2048) {
        int q = t - 64 - 2176;
        int b = q >> 9, k1 = (q >> 3) & 63, cb = q & 7;
        fft2_task(p, b * 4096 + k1 * 64, cb, 1.f / 64.f, smem);
      } else {
        int q = t - 64 - 2176 - 2048;
        int b = q >> 5, k1 = (q >> 3) & 3, cb = q & 7;
        if (!last) fft2_task(p, NLAT + b * 256 + k1 * 64, cb, 1.f / 16.f, smem);
      }
    }
  } else if (s == 3) {
    const int total = 4096 + 544 + 544;
    for (int t = b0; t < total; t += nb) {
      if (t < 4096) ssd_p2_task(p, t);
      else if (t < 4096 + 544) s5_gemm_task<true>(p, t - 4096);
      else {
        int q = t - 4096 - 544;
        int mt = q >> 2, nt = q & 3;
        if (!(last && mt >= 128)) gemm_tile<2>(p, l, mt, nt, smem);
      }
    }
  } else if (s == 4) {
    const int total = 2176 + 544;
    for (int t = b0; t < total; t += nb) {
      if (t < 2176) ssd_p3_task(p, l, t, smem);
      else {
        int q = t - 2176;
        int mt = q >> 2, nt = q & 3;
        if (!(last && mt >= 128)) gemm_tile<3>(p, l, mt, nt, smem);
      }
    }
  } else if (s == 5) {
    const int nmt = last ? 128 : 136;
    for (int t = b0; t < nmt * 8; t += nb) gemm_tile<1>(p, l, t >> 3, t & 7, smem);
  } else {
    const int total = 4352 + (last ? 0 : PREP_TASKS);
    for (int t = b0; t < total; t += nb) {
      if (!last && t < PREP_TASKS) prep_task(p, l + 1, t, smem);
      else resid_task(p, l, t - (last ? 0 : PREP_TASKS));
    }
  }
}

__global__ void __launch_bounds__(256, 2) mega_kernel(Params p, int ph0, int ph1, int coop) {
  __shared__ __attribute__((aligned(16))) char smem[SMEM_BYTES];
  cg::grid_group grid = cg::this_grid();
  for (int ph = ph0; ph < ph1; ph++) {
    run_phase(p, ph, smem);
    if (coop && ph + 1 < ph1) grid.sync();
  }
}

__global__ void fill_kernel(float* o, int n, float v) {
  int i = blockIdx.x * 256 + threadIdx.x;
  if (i < n) o[i] = v;
}

extern "C" void kernel_launch(void* const* d_in, const int* in_sizes, int n_in, void* d_out, int out_size, void* d_ws,
                              size_t ws_size, hipStream_t stream) {
  static int grid_blocks = 0;
  if (!grid_blocks) {
    int dev = 0, cus = 0, per_cu = 0;
    hipGetDevice(&dev);
    hipDeviceGetAttribute(&cus, hipDeviceAttributeMultiprocessorCount, dev);
    hipOccupancyMaxActiveBlocksPerMultiprocessor(&per_cu, mega_kernel, 256, 0);
    if (per_cu < 1) per_cu = 1;
    if (per_cu > 2) per_cu = 2;
    grid_blocks = cus * per_cu;
  }
  if (ws_size < WS_NEED || n_in != 28) {
    fill_kernel<<<(out_size + 255) / 256, 256, 0, stream>>>((float*)d_out, out_size, 7777.f);
    return;
  }
  Params p{};
  const float** pp = (const float**)&p;
  for (int i = 0; i < 28; i++) pp[i] = (const float*)d_in[i];
  p.out = (float*)d_out;
  p.ws = (char*)d_ws;
  const int NPH = 2 + 7 * NLAYER;
#if MULTI_LAUNCH
  for (int ph = 0; ph < NPH; ph++) {
    hipLaunchKernelGGL(mega_kernel, dim3(grid_blocks), dim3(256), 0, stream, p, ph, ph + 1, 0);
  }
#else
  int ph0 = 0, ph1 = NPH, coop = 1;
  void* args[] = {&p, &ph0, &ph1, &coop};
  hipError_t e = hipLaunchCooperativeKernel((void*)mega_kernel, dim3(grid_blocks), dim3(256), args, 0, stream);
  if (e != hipSuccess) fprintf(stderr, "cooperative launch failed: %s (grid %d)\n", hipGetErrorString(e), grid_blocks);
#endif
}
```
